# Optimizing an MI355X kernel written in HIP

```python
import jax, jax.numpy as jnp
from jax import lax
import numpy as np

D_MODEL = 1024
BATCH = 4
SEQ = 8192
DEPTH = 4

HEAD_DIM = 64
D_RNN = D_MODEL // 2
H_RNN = D_RNN // HEAD_DIM
RNN_BLOCK = D_RNN // H_RNN
CONV_W = 4
RG_C = 8.0
H_FOX = (D_MODEL // 2) // HEAD_DIM
FOX_W = H_FOX * HEAD_DIM
H_SB = D_MODEL // HEAD_DIM
SB_W = H_SB * HEAD_DIM
D_FF = 11 * D_MODEL // 4
Q_BLOCK = 128
RMS_EPS = 1e-6
N_EVEN = (DEPTH + 1) // 2
N_ODD = DEPTH // 2
HY_IN = 2 * D_RNN + 3 * FOX_W + H_FOX
HY_MIX = D_RNN + FOX_W

kernel_name = "hybrid_rglru_fox_stickbreak_macaron"


def _rmsnorm(x, g):
    x32 = x.astype(jnp.float32)
    y = x32 * lax.rsqrt(jnp.mean(x32 * x32, axis=-1, keepdims=True) + RMS_EPS)
    return (y * g.astype(jnp.float32)).astype(x.dtype)


def _swiglu(h, w_in, w_out):
    a, b = jnp.split(h @ w_in, 2, axis=-1)
    return (jax.nn.silu(a) * b) @ w_out


def _lin_combine(left, right):
    a1, b1 = left
    a2, b2 = right
    return a1 * a2, a2 * b1 + b2


def _rglru_branch(u, gate, conv_w, conv_b, gate_w, gate_b, lam):
    B, S, _ = u.shape
    up = jnp.pad(u, ((0, 0), (CONV_W - 1, 0), (0, 0)))
    xc = conv_b + sum(conv_w[j] * up[:, j:j + S] for j in range(CONV_W))
    xh = xc.reshape(B, S, H_RNN, RNN_BLOCK)
    g = jnp.einsum('bshi,ghij->gbshj', xh, gate_w).reshape(2, B, S, D_RNN) + gate_b[:, None, None, :]
    r = jax.nn.sigmoid(g[0].astype(jnp.float32))
    i = jax.nn.sigmoid(g[1].astype(jnp.float32))
    log_a = -RG_C * r * jax.nn.softplus(-lam.astype(jnp.float32))
    a = jnp.exp(log_a)
    b = jnp.sqrt(-jnp.expm1(2.0 * log_a)) * (i * xc.astype(jnp.float32))
    _, h = lax.associative_scan(_lin_combine, (a, b), axis=1)
    return h.astype(u.dtype) * jax.nn.gelu(gate)


def _to_query_blocks(q):
    B, H, S, d = q.shape
    return q.reshape(B, H, S // Q_BLOCK, Q_BLOCK, d).transpose(2, 0, 1, 3, 4)


def _from_query_blocks(o):
    nb, B, H, QB, d = o.shape
    return o.transpose(1, 0, 3, 2, 4).reshape(B, nb * QB, H * d)


def _fox_attention(q, k, v, logf):
    B, H, S, d = q.shape
    c = jnp.cumsum(logf, axis=-1)
    nb = S // Q_BLOCK
    qb = _to_query_blocks(q)
    cb = c.reshape(B, H, nb, Q_BLOCK).transpose(2, 0, 1, 3)
    kpos = jnp.arange(S)
    scale = d ** -0.5

    def block(args):
        qi, ci, bi = args
        qpos = bi * Q_BLOCK + jnp.arange(Q_BLOCK)
        s = jnp.einsum('bhqd,bhkd->bhqk', qi, k).astype(jnp.float32) * scale
        s = s + ci[..., None] - c[:, :, None, :]
        s = jnp.where(kpos[None, :] <= qpos[:, None], s, -jnp.inf)
        p = jax.nn.softmax(s, axis=-1)
        return jnp.einsum('bhqk,bhkd->bhqd', p.astype(v.dtype), v)

    return _from_query_blocks(lax.map(block, (qb, cb, jnp.arange(nb))))


def _stick_breaking_attention(q, k, v):
    B, H, S, d = q.shape
    nb = S // Q_BLOCK
    qb = _to_query_blocks(q)
    kpos = jnp.arange(S)
    scale = d ** -0.5

    def block(args):
        qi, bi = args
        qpos = bi * Q_BLOCK + jnp.arange(Q_BLOCK)
        mask = kpos[None, :] < qpos[:, None]
        z = jnp.einsum('bhqd,bhkd->bhqk', qi, k).astype(jnp.float32) * scale
        log_nb = jnp.where(mask, jax.nn.log_sigmoid(-z), 0.0)
        after = lax.cumsum(log_nb, axis=3, reverse=True) - log_nb
        w = jnp.where(mask, jnp.exp(jax.nn.log_sigmoid(z) + after), 0.0)
        return jnp.einsum('bhqk,bhkd->bhqd', w.astype(v.dtype), v)

    return _from_query_blocks(lax.map(block, (qb, jnp.arange(nb))))


def _heads(t, n):
    B, S, _ = t.shape
    return t.reshape(B, S, n, HEAD_DIM)


def _hybrid_mixer(h, w_in, conv_w, conv_b, gate_w, gate_b, lam, f_b, qk_g, w_out):
    proj = h @ w_in
    o = 2 * D_RNN
    u, gate, q, k, v, f = jnp.split(proj, [D_RNN, o, o + FOX_W, o + 2 * FOX_W, o + 3 * FOX_W], axis=-1)
    y_rnn = _rglru_branch(u, gate, conv_w, conv_b, gate_w, gate_b, lam)
    qh = _rmsnorm(_heads(q, H_FOX), qk_g[0]).transpose(0, 2, 1, 3)
    kh = _rmsnorm(_heads(k, H_FOX), qk_g[1]).transpose(0, 2, 1, 3)
    vh = _heads(v, H_FOX).transpose(0, 2, 1, 3)
    logf = jax.nn.log_sigmoid((f + f_b).astype(jnp.float32)).transpose(0, 2, 1)
    y_fox = _fox_attention(qh, kh, vh, logf)
    return jnp.concatenate([y_rnn, y_fox], axis=-1) @ w_out


def _sb_mixer(h, w_qkv, w_out):
    q, k, v = jnp.split(h @ w_qkv, 3, axis=-1)
    qh, kh, vh = (_heads(t, H_SB).transpose(0, 2, 1, 3) for t in (q, k, v))
    return _stick_breaking_attention(qh, kh, vh) @ w_out


def setup_inputs(seed: int = 0) -> dict:
    key = jax.random.key(seed)
    ks = jax.random.split(key, 20)
    f32 = jnp.float32

    def nrm(k, shape, fan_in):
        return jax.random.normal(k, shape, f32) * (fan_in ** -0.5)

    a0 = jax.random.uniform(ks[9], (N_EVEN, D_RNN), f32, 0.9, 0.999)
    return {
        "x": jax.random.normal(ks[0], (BATCH, SEQ, D_MODEL), f32),
        "ffn_norm": 1.0 + 0.05 * jax.random.normal(ks[1], (DEPTH, 2, D_MODEL), f32),
        "ffn_w_in": nrm(ks[2], (DEPTH, 2, D_MODEL, 2 * D_FF), D_MODEL),
        "ffn_w_out": nrm(ks[3], (DEPTH, 2, D_FF, D_MODEL), D_FF),
        "mix_norm": 1.0 + 0.05 * jax.random.normal(ks[4], (DEPTH, D_MODEL), f32),
        "hy_w_in": nrm(ks[5], (N_EVEN, D_MODEL, HY_IN), D_MODEL),
        "rg_conv_w": nrm(ks[6], (N_EVEN, CONV_W, D_RNN), CONV_W),
        "rg_conv_b": 0.02 * jax.random.normal(ks[7], (N_EVEN, D_RNN), f32),
        "rg_gate_w": nrm(ks[8], (N_EVEN, 2, H_RNN, RNN_BLOCK, RNN_BLOCK), RNN_BLOCK),
        "rg_gate_b": 0.02 * jax.random.normal(ks[10], (N_EVEN, 2, D_RNN), f32),
        "rg_lambda": jnp.log(a0) - jnp.log1p(-a0),
        "fox_fgate_b": jax.random.uniform(ks[11], (N_EVEN, H_FOX), f32, 1.0, 4.0),
        "fox_qk_norm": 1.0 + 0.05 * jax.random.normal(ks[12], (N_EVEN, 2, HEAD_DIM), f32),
        "hy_w_out": nrm(ks[13], (N_EVEN, HY_MIX, D_MODEL), HY_MIX),
        "sb_w_qkv": nrm(ks[14], (N_ODD, D_MODEL, 3 * SB_W), D_MODEL),
        "sb_w_out": nrm(ks[15], (N_ODD, SB_W, D_MODEL), SB_W),
    }


def reference(x, ffn_norm, ffn_w_in, ffn_w_out, mix_norm, hy_w_in, rg_conv_w, rg_conv_b,
              rg_gate_w, rg_gate_b, rg_lambda, fox_fgate_b, fox_qk_norm, hy_w_out,
              sb_w_qkv, sb_w_out):
    for layer in range(DEPTH):
        x = x + 0.5 * _swiglu(_rmsnorm(x, ffn_norm[layer, 0]), ffn_w_in[layer, 0], ffn_w_out[layer, 0])
        h = _rmsnorm(x, mix_norm[layer])
        if layer % 2 == 0:
            e = layer // 2
            y = _hybrid_mixer(h, hy_w_in[e], rg_conv_w[e], rg_conv_b[e], rg_gate_w[e], rg_gate_b[e],
                              rg_lambda[e], fox_fgate_b[e], fox_qk_norm[e], hy_w_out[e])
        else:
            o = layer // 2
            y = _sb_mixer(h, sb_w_qkv[o], sb_w_out[o])
        x = x + y
        x = x + 0.5 * _swiglu(_rmsnorm(x, ffn_norm[layer, 1]), ffn_w_in[layer, 1], ffn_w_out[layer, 1])
    return x
```

```cpp
#include <hip/hip_runtime.h>
#include <hip/hip_cooperative_groups.h>
#include <cstdio>
#include <cstdint>
namespace cg = cooperative_groups;
#define DI __device__ __forceinline__
#define REP_SB 1
#define REP_FOX 1
#define REP_SYNC 1
#define REP_P0 1
#define REP_PA 1
#define REP_F1 1
#define REP_ST0 1
#define REP_ST1 1
namespace pg8 {
#define PG8_LAS __attribute__((address_space(3)))
typedef unsigned short bf16_t;
typedef short bf16x8 __attribute__((ext_vector_type(8)));
typedef float f32x4 __attribute__((ext_vector_type(4)));
typedef unsigned u32x4 __attribute__((ext_vector_type(4)));
typedef _Float16 h16x8 __attribute__((ext_vector_type(8)));
constexpr int BM = 256, BK = 64, HALF = 128, HTB = HALF * BK * 2  , STAGE_BYTES = 8 * HTB, NXCD = 8, WGM = 8;

__host__ __device__ __forceinline__ int lds_byte(int r, int c) { const int st = (r >> 4) * 2 + (c >> 5), rr = r & 15, cc = c & 31, ob = rr * 64 + cc * 2; return st * 1024 + (ob ^ (((ob >> 9) & 1) << 5)); }
__host__ __device__ __forceinline__ void stage_rc(int b, int& R, int& C) { const int st = b / 1024, sb = b % 1024, swz = sb ^ (((sb >> 9) & 1) << 5); R = (st >> 1) * 16 + swz / 64; C = (st & 1) * 32 + (swz % 64) / 2; }
__host__ __device__ __forceinline__ int perm32(int rho) { const int n = rho >> 4, i = rho & 15; return 8 * (i >> 2) + 4 * n + (i & 3); }

struct Unit { int pm, pn; };
struct Gemm { const bf16_t* A; const bf16_t* Bt; int M, N, K; };

struct StaticOrder {
    int nM, nN, nwg, G, c;
    __host__ __device__ void init(int M, int N, int G_, int c_) { nM = M / BM; nN = N / BM; nwg = nM * nN; G = G_; c = c_; }
    __host__ __device__ bool next(int i, Unit& u) const {
        const long L = (long)i * G + c; if (L >= nwg) return false;
        int wgid = (int)L; { const int q = nwg / NXCD, r = nwg % NXCD, xcd = wgid % NXCD, off = wgid / NXCD; wgid = (xcd < r ? xcd * (q + 1) : r * (q + 1) + (xcd - r) * q) + off; }
        const int nig = WGM * nN, gid = wgid / nig, fm = gid * WGM, gsz = (nM - fm) < WGM ? (nM - fm) : WGM;
        u.pm = fm + ((wgid % nig) % gsz); u.pn = (wgid % nig) / gsz; return true;
    }
    __device__ __forceinline__ void a_ready(const Unit&) const {}
    __device__ __forceinline__ void done(const Unit&) const {}
};

__device__ __forceinline__ unsigned cvt_pk_bf16(float lo, float hi) { unsigned r; asm volatile("v_cvt_pk_bf16_f32 %0, %1, %2" : "=v"(r) : "v"(lo), "v"(hi)); return r; }
constexpr float RMS_EPS_F = 1e-6f;
#define PG8_GAS __attribute__((address_space(1)))
__device__ __forceinline__ float rowscale(const float* ssq, int row) {
    const PG8_GAS f32x4* p = (const PG8_GAS f32x4*)(ssq + (size_t)row * 16);
    const f32x4 a = p[0], b = p[1], c = p[2], d = p[3];
    const float s = ((a[0] + a[1]) + (a[2] + a[3])) + ((b[0] + b[1]) + (b[2] + b[3])) + ((c[0] + c[1]) + (c[2] + c[3])) + ((d[0] + d[1]) + (d[2] + d[3]));
    return __builtin_amdgcn_rsqf(s * (1.0f / 1024.0f) + RMS_EPS_F);
}
__device__ __forceinline__ float silu_f(float a) { return a * __builtin_amdgcn_rcpf(1.0f + __builtin_amdgcn_exp2f(-1.4426950408889634f * a)); }
struct EpiSwiglu {
    static constexpr bool PERM = true, AFTER_DRAIN = false;
    bf16_t* H; int ldh; const float* ssq;
    __device__ __forceinline__ void operator()(const f32x4 (&acc)[2][2][4][2], const Unit& u, int wr, int wc, int fr, int fq) const {
        const int row0 = u.pm * BM + wr * 64 + fr, col0 = u.pn * HALF + wc * 32 + 8 * fq;
        float rs[2][4];
        { const int l64 = fr + 16 * fq; float rsl[2];
#pragma unroll
          for (int ai = 0; ai < 2; ++ai) rsl[ai] = rowscale(ssq, u.pm * BM + ai * HALF + wr * 64 + l64);
#pragma unroll
          for (int ai = 0; ai < 2; ++ai)
#pragma unroll
              for (int m = 0; m < 4; ++m) rs[ai][m] = __shfl(rsl[ai], m * 16 + fr); }
#pragma unroll
        for (int ai = 0; ai < 2; ++ai)
#pragma unroll
            for (int m = 0; m < 4; ++m) { const int row = row0 + ai * HALF + m * 16; const float r_ = rs[ai][m];
                typedef float f32x2v __attribute__((ext_vector_type(2)));
                const float k_ = -1.4426950408889634f * r_, r2_ = r_ * r_;
                unsigned wq[4];
#pragma unroll
                for (int q = 0; q < 4; ++q) { const f32x4 av = acc[ai][0][m][q >> 1], bv = acc[ai][1][m][q >> 1];
                    const f32x2v a2 = {av[2 * (q & 1)], av[2 * (q & 1) + 1]}, b2 = {bv[2 * (q & 1)], bv[2 * (q & 1) + 1]};
                    const f32x2v t2 = a2 * k_; f32x2v e2; e2.x = __builtin_amdgcn_exp2f(t2.x); e2.y = __builtin_amdgcn_exp2f(t2.y);
                    const f32x2v d2 = e2 + 1.0f; f32x2v i2; i2.x = __builtin_amdgcn_rcpf(d2.x); i2.y = __builtin_amdgcn_rcpf(d2.y);
                    const f32x2v h2 = ((a2 * b2) * r2_) * i2; wq[q] = cvt_pk_bf16(h2.x, h2.y); }
                u32x4 w; w.x = wq[0]; w.y = wq[1]; w.z = wq[2]; w.w = wq[3];
                *(PG8_GAS u32x4*)(H + (size_t)row * ldh + col0) = w; }
    }
};
struct EpiRes {
    static constexpr bool PERM = true, AFTER_DRAIN = false;
    float* xout; _Float16* xh; float* ssq; float alpha;
    __device__ __forceinline__ void operator()(const f32x4 (&acc)[2][2][4][2], const Unit& u, int wr, int wc, int fr, int fq) const {
        const int row0 = u.pm * BM + wr * 64 + fr, col0 = u.pn * BM + wc * 32 + 8 * fq;
#pragma unroll
        for (int ai = 0; ai < 2; ++ai) {
            u32x4 xv[4][2];
#pragma unroll
            for (int m = 0; m < 4; ++m)
#pragma unroll
                for (int bj = 0; bj < 2; ++bj) xv[m][bj] = *(const PG8_GAS u32x4*)(xh + (size_t)(row0 + ai * HALF + m * 16) * 1024 + col0 + bj * HALF);
#pragma unroll
            for (int m = 0; m < 4; ++m) { const int row = row0 + ai * HALF + m * 16; float ss = 0.f;
#pragma unroll
                for (int bj = 0; bj < 2; ++bj) { const size_t off = (size_t)row * 1024 + col0 + bj * HALF; const u32x4 r = xv[m][bj];
                    const h16x8 hv = __builtin_bit_cast(h16x8, r);
                    f32x4 x0 = {(float)hv[0], (float)hv[1], (float)hv[2], (float)hv[3]}, x1 = {(float)hv[4], (float)hv[5], (float)hv[6], (float)hv[7]};
                    x0 = x0 + acc[ai][bj][m][0] * alpha; x1 = x1 + acc[ai][bj][m][1] * alpha;
                    if (xout) { *(PG8_GAS f32x4*)(xout + off) = x0; *(PG8_GAS f32x4*)(xout + off + 4) = x1; }
                    const h16x8 ho = {(_Float16)x0[0], (_Float16)x0[1], (_Float16)x0[2], (_Float16)x0[3], (_Float16)x1[0], (_Float16)x1[1], (_Float16)x1[2], (_Float16)x1[3]};
                    *(PG8_GAS u32x4*)(xh + off) = __builtin_bit_cast(u32x4, ho);
                    ss += (x0[0] * x0[0] + x0[1] * x0[1]) + (x0[2] * x0[2] + x0[3] * x0[3]) + (x1[0] * x1[0] + x1[1] * x1[1]) + (x1[2] * x1[2] + x1[3] * x1[3]); }
                ss += __shfl_xor(ss, 16); ss += __shfl_xor(ss, 32);
                if (fq == 0) *(PG8_GAS float*)(ssq + (size_t)row * 16 + u.pn * 4 + wc) = ss; }
        }
    }
};
struct EpiProj {
    static constexpr bool PERM = true, AFTER_DRAIN = false;
    bf16_t* O; int ldc; const float* ssq; int qcols; float qscale;
    __device__ __forceinline__ void operator()(const f32x4 (&acc)[2][2][4][2], const Unit& u, int wr, int wc, int fr, int fq) const {
        const int row0 = u.pm * BM + wr * 64 + fr, col0 = u.pn * BM + wc * 32 + 8 * fq;
        float rs[2][4];
        { const int l64 = fr + 16 * fq; float rsl[2];
#pragma unroll
          for (int ai = 0; ai < 2; ++ai) rsl[ai] = rowscale(ssq, u.pm * BM + ai * HALF + wr * 64 + l64);
#pragma unroll
          for (int ai = 0; ai < 2; ++ai)
#pragma unroll
              for (int m = 0; m < 4; ++m) rs[ai][m] = __shfl(rsl[ai], m * 16 + fr); }
#pragma unroll
        for (int ai = 0; ai < 2; ++ai)
#pragma unroll
            for (int m = 0; m < 4; ++m) { const int row = row0 + ai * HALF + m * 16;
#pragma unroll
                for (int bj = 0; bj < 2; ++bj) { const int col = col0 + bj * HALF; const float sc = rs[ai][m] * (col < qcols ? qscale : 1.0f);
                    const f32x4 v0 = acc[ai][bj][m][0] * sc, v1 = acc[ai][bj][m][1] * sc;
                    u32x4 w; w.x = cvt_pk_bf16(v0[0], v0[1]); w.y = cvt_pk_bf16(v0[2], v0[3]); w.z = cvt_pk_bf16(v1[0], v1[1]); w.w = cvt_pk_bf16(v1[2], v1[3]);
                    *(PG8_GAS u32x4*)(O + (size_t)row * ldc + col) = w; } }
    }
};

template <bool F16> __device__ __forceinline__ f32x4 mma16(const bf16x8 a, const bf16x8 b, const f32x4 c) {
    if constexpr (F16) return __builtin_amdgcn_mfma_f32_16x16x32_f16(__builtin_bit_cast(h16x8, a), __builtin_bit_cast(h16x8, b), c, 0, 0, 0);
    else return __builtin_amdgcn_mfma_f32_16x16x32_bf16(a, b, c, 0, 0, 0);
}
template <class Epi, class Sched, bool ALIGN_EPI = false, bool SP2 = false, bool F16 = false>
__device__ __forceinline__ void gemm_phase(PG8_LAS unsigned char* lds, const Gemm g, const Sched& S, const Epi& E, const int tid) {
    const int wid = __builtin_amdgcn_readfirstlane(tid >> 6), lane = tid & 63, wr = wid >> 2, wc = wid & 3, fr = lane & 15, fq = lane >> 4;
    const int K = g.K, nt = K / BK;
    unsigned voffA[2], voffB[2];
#pragma unroll
    for (int i = 0; i < 2; ++i) { int R, C; stage_rc(tid * 16 + i * 8192, R, C); const int Rb = Epi::PERM ? ((R & ~31) + perm32(R & 31)) : R;
        voffA[i] = (unsigned)(R * K + C) * 2u; voffB[i] = (unsigned)(tid * 16 + i * 8192); (void)Rb; }
    const size_t kstep = (size_t)(BK * 2);
    const size_t hstep = (size_t)HALF * K * 2;
    const size_t tstep = 2 * hstep;
    const size_t kstepB = 32768, hstepB = 16384, tstepB = (size_t)nt * 32768;
    const unsigned ldsw = (unsigned)wid * 1024u;
    const int aoff = lds_byte(wr * 64 + fr, fq * 8), boff = lds_byte(wc * 32 + fr, fq * 8);
#define PG8_SA(b, h) (((b) * 2 + (h)) * HTB)
#define PG8_SB(b, h) ((4 + (b) * 2 + (h)) * HTB)
#define PG8_STAGE(bufoff, gbase, voff) do { _Pragma("unroll") for (int _i = 0; _i < 2; ++_i) \
        __builtin_amdgcn_global_load_lds((const unsigned*)((const char*)(gbase) + (voff)[_i]), (PG8_LAS unsigned*)(lds + (bufoff) + ldsw + _i * 8192), 16, 0, 0); } while (0)
#define PG8_LDA(dst, b, h) do { _Pragma("unroll") for (int m = 0; m < 4; ++m) _Pragma("unroll") for (int k = 0; k < 2; ++k) dst[m][k] = *(const PG8_LAS bf16x8*)(lds + PG8_SA(b, h) + aoff + m * 2048 + k * 1024); } while (0)
#define PG8_LDB(dst, b, h) do { _Pragma("unroll") for (int n = 0; n < 2; ++n) _Pragma("unroll") for (int k = 0; k < 2; ++k) dst[n][k] = *(const PG8_LAS bf16x8*)(lds + PG8_SB(b, h) + boff + n * 2048 + k * 1024); } while (0)
#define PG8_MMA(ai, bj, At, Bt) do { __builtin_amdgcn_s_setprio(1); _Pragma("unroll") for (int m = 0; m < 4; ++m) _Pragma("unroll") for (int n = 0; n < 2; ++n) _Pragma("unroll") for (int k = 0; k < 2; ++k) \
        acc[ai][bj][m][n] = mma16<F16>(Bt[n][k], At[m][k], acc[ai][bj][m][n]); __builtin_amdgcn_s_setprio(0); } while (0)
#define PG8_WAIT_V(n) asm volatile("s_waitcnt vmcnt(" #n ")" ::: "memory")
#define PG8_WAIT_L(n) asm volatile("s_waitcnt lgkmcnt(" #n ")" ::: "memory")
#define PG8_BAR __builtin_amdgcn_s_barrier()
#define PG8_SCHED __builtin_amdgcn_sched_barrier(0)
    Unit cur, nxt; int ui = 0;
    if (!S.next(0, cur)) return;
    f32x4 acc[2][2][4][2];
#pragma unroll
    for (int a = 0; a < 2; ++a)
#pragma unroll
        for (int b = 0; b < 2; ++b)
#pragma unroll
            for (int m = 0; m < 4; ++m)
#pragma unroll
                for (int n = 0; n < 2; ++n) acc[a][b][m][n] = (f32x4){0.f, 0.f, 0.f, 0.f};
    bf16x8 At[4][2], B0[2][2], B1[2][2];
    const char* cA = (const char*)g.A + (size_t)cur.pm * tstep; const char* cB = (const char*)g.Bt + (size_t)cur.pn * tstepB;
    S.a_ready(cur);
    if constexpr (SP2) {
        PG8_STAGE(PG8_SB(0, 0), cB, voffB); PG8_STAGE(PG8_SB(0, 1), cB + hstepB, voffB); PG8_STAGE(PG8_SA(0, 0), cA, voffA); PG8_STAGE(PG8_SA(0, 1), cA + hstep, voffA);
        if (wr == 1) PG8_BAR;
        PG8_WAIT_V(2); PG8_BAR;
        PG8_STAGE(PG8_SB(1, 0), cB + kstepB, voffB); PG8_STAGE(PG8_SA(1, 0), cA + kstep, voffA); PG8_STAGE(PG8_SB(1, 1), cB + hstepB + kstepB, voffB);
        PG8_WAIT_V(6); PG8_BAR;
    } else {
        PG8_STAGE(PG8_SB(0, 0), cB, voffB); PG8_STAGE(PG8_SA(0, 0), cA, voffA); PG8_STAGE(PG8_SB(0, 1), cB + hstepB, voffB); PG8_STAGE(PG8_SA(0, 1), cA + hstep, voffA);
        if (wr == 1) PG8_BAR;
        PG8_WAIT_V(4); PG8_BAR;
        PG8_STAGE(PG8_SB(1, 0), cB + kstepB, voffB); PG8_STAGE(PG8_SA(1, 0), cA + kstep, voffA); PG8_STAGE(PG8_SB(1, 1), cB + hstepB + kstepB, voffB);
        PG8_WAIT_V(6); PG8_BAR;
    }
    for (;;) {
        const bool has_next = S.next(ui + 1, nxt);
        const char* nA = has_next ? (const char*)g.A + (size_t)nxt.pm * tstep : cA; const char* nB = has_next ? (const char*)g.Bt + (size_t)nxt.pn * tstepB : cB;
        for (int t = 0; t < nt; t += 2) {
            const bool last = (t == nt - 2);
            const char* a1 = cA + (size_t)(t + 1) * kstep;
            const char* a2 = last ? nA : cA + (size_t)(t + 2) * kstep; const char* b2 = last ? nB : cB + (size_t)(t + 2) * kstepB;
            const char* a3 = a2 + kstep; const char* b3 = b2 + kstepB;
            if (last && has_next) S.a_ready(nxt);
            if constexpr (SP2) {
            PG8_LDB(B0, 0, 0); PG8_LDB(B1, 0, 1); PG8_SCHED; PG8_LDA(At, 0, 0); PG8_STAGE(PG8_SA(1, 1), a1 + hstep, voffA);
            PG8_WAIT_V(8); PG8_WAIT_L(0); PG8_BAR; PG8_MMA(0, 0, At, B0); PG8_MMA(0, 1, At, B1); PG8_BAR; PG8_SCHED;
            PG8_LDA(At, 0, 1); PG8_STAGE(PG8_SB(0, 0), b2, voffB); PG8_STAGE(PG8_SB(0, 1), b2 + hstepB, voffB); PG8_STAGE(PG8_SA(0, 0), a2, voffA);
            PG8_WAIT_V(8); PG8_WAIT_L(0); PG8_BAR; PG8_MMA(1, 0, At, B0); PG8_MMA(1, 1, At, B1); PG8_BAR; PG8_SCHED;
            PG8_LDB(B0, 1, 0); PG8_LDB(B1, 1, 1); PG8_SCHED; PG8_LDA(At, 1, 0); PG8_STAGE(PG8_SA(0, 1), a2 + hstep, voffA);
            PG8_WAIT_V(8); PG8_WAIT_L(0); PG8_BAR; PG8_MMA(0, 0, At, B0); PG8_MMA(0, 1, At, B1); PG8_BAR; PG8_SCHED;
            PG8_LDA(At, 1, 1); PG8_STAGE(PG8_SB(1, 0), b3, voffB); PG8_STAGE(PG8_SB(1, 1), b3 + hstepB, voffB); PG8_STAGE(PG8_SA(1, 0), a3, voffA);
            PG8_WAIT_V(8); PG8_WAIT_L(0); PG8_BAR; PG8_MMA(1, 0, At, B0); PG8_MMA(1, 1, At, B1); PG8_BAR; PG8_SCHED;
            } else {
            PG8_LDB(B0, 0, 0); PG8_SCHED; PG8_LDA(At, 0, 0); PG8_STAGE(PG8_SA(1, 1), a1 + hstep, voffA);
            PG8_WAIT_L(8); PG8_BAR; PG8_WAIT_L(0); PG8_MMA(0, 0, At, B0); PG8_BAR; PG8_SCHED;
            PG8_LDB(B1, 0, 1); PG8_STAGE(PG8_SB(0, 0), b2, voffB);
            PG8_BAR; PG8_WAIT_L(0); PG8_MMA(0, 1, At, B1); PG8_BAR;
            PG8_LDA(At, 0, 1); PG8_STAGE(PG8_SA(0, 0), a2, voffA);
            PG8_BAR; PG8_WAIT_L(0); PG8_MMA(1, 0, At, B0); PG8_BAR; PG8_SCHED;
            PG8_STAGE(PG8_SB(0, 1), b2 + hstepB, voffB);
            PG8_WAIT_V(6); PG8_BAR; PG8_MMA(1, 1, At, B1); PG8_BAR;
            PG8_LDB(B0, 1, 0); PG8_SCHED; PG8_LDA(At, 1, 0); PG8_STAGE(PG8_SA(0, 1), a2 + hstep, voffA);
            PG8_WAIT_L(8); PG8_BAR; PG8_WAIT_L(0); PG8_MMA(0, 0, At, B0); PG8_BAR; PG8_SCHED;
            PG8_LDB(B1, 1, 1); PG8_STAGE(PG8_SB(1, 0), b3, voffB);
            PG8_BAR; PG8_WAIT_L(0); PG8_MMA(0, 1, At, B1); PG8_BAR;
            PG8_LDA(At, 1, 1); PG8_STAGE(PG8_SA(1, 0), a3, voffA);
            PG8_BAR; PG8_WAIT_L(0); PG8_MMA(1, 0, At, B0); PG8_BAR; PG8_SCHED;
            PG8_STAGE(PG8_SB(1, 1), b3 + hstepB, voffB);
            PG8_WAIT_V(6); PG8_BAR; PG8_MMA(1, 1, At, B1); PG8_BAR;
            }
        }
        if constexpr (ALIGN_EPI) { if (wr == 0) PG8_BAR; }
        if constexpr (!Epi::AFTER_DRAIN) { E(acc, cur, wr, wc, fr, fq); S.done(cur); }
        if (!has_next) break;
#pragma unroll
        for (int a = 0; a < 2; ++a)
#pragma unroll
            for (int b = 0; b < 2; ++b)
#pragma unroll
                for (int m = 0; m < 4; ++m)
#pragma unroll
                    for (int n = 0; n < 2; ++n) acc[a][b][m][n] = (f32x4){0.f, 0.f, 0.f, 0.f};
        cur = nxt; cA = nA; cB = nB; ++ui;
        if constexpr (ALIGN_EPI) { if (wr == 1) PG8_BAR; }
    }
    PG8_WAIT_V(0);
    if constexpr (!ALIGN_EPI) { if (wr == 0) PG8_BAR; }
    PG8_BAR;
    if constexpr (Epi::AFTER_DRAIN) { E.fused(acc, cur, wr, wc, fr, fq, lds, wid, lane); S.done(cur); }
#undef PG8_SA
#undef PG8_SB
#undef PG8_STAGE
#undef PG8_LDA
#undef PG8_LDB
#undef PG8_MMA
#undef PG8_WAIT_V
#undef PG8_WAIT_L
#undef PG8_BAR
#undef PG8_SCHED
}
}
using pg8::bf16_t; using pg8::bf16x8; using pg8::f32x4; using pg8::u32x4;
#define LAS __attribute__((address_space(3)))
typedef float f32x16 __attribute__((ext_vector_type(16)));
typedef short s16x4 __attribute__((ext_vector_type(4)));
typedef float f32x2_t __attribute__((ext_vector_type(2)));
typedef __bf16 bf16x2_t __attribute__((ext_vector_type(2)));
#define LDS_WAIT() asm volatile("s_waitcnt lgkmcnt(0)" ::: "memory")
#define MFMA32(a, b, c) __builtin_amdgcn_mfma_f32_32x32x16_bf16((a), (b), (c), 0, 0, 0)

constexpr int NB = 4, SEQ = 8192, TOK = NB * SEQ, DM = 1024, DFF = 2816, DRNN = 512, HYW = 2816, HYIN = 2568, SBW = 3072, NCHUNK = SEQ / 128;
constexpr float LOG2E = 1.4426950408889634f, QSC = 0.125f * 1.4426950408889634f;
constexpr size_t SZ_WFI = (size_t)2 * DFF * DM * 2, SZ_WFO = (size_t)DM * DFF * 2, SZ_WHI = (size_t)HYW * DM * 2, SZ_W1K = (size_t)DM * DM * 2, SZ_WSQ = (size_t)SBW * DM * 2;
constexpr size_t WS_WFI = 0, WS_WFO = WS_WFI + 8 * SZ_WFI, WS_WHI = WS_WFO + 8 * SZ_WFO, WS_WHO = WS_WHI + 2 * SZ_WHI, WS_WSQ = WS_WHO + 2 * SZ_W1K, WS_WSO = WS_WSQ + 2 * SZ_WSQ;
constexpr size_t WS_XB = WS_WSO + 2 * SZ_W1K, WS_SSQ = WS_XB + (size_t)TOK * DM * 2, WS_BIG = WS_SSQ + (size_t)TOK * 16 * 4, WS_YB = WS_BIG + (size_t)TOK * SBW * 2;
constexpr size_t WS_HL = WS_YB + (size_t)TOK * DM * 2, WS_PL = WS_HL + (size_t)TOK * DRNN * 4, WS_CA = WS_PL + (size_t)TOK * DRNN * 4, WS_CB = WS_CA + (size_t)NB * NCHUNK * DRNN * 4;
constexpr size_t WS_CL = WS_CB + (size_t)NB * NCHUNK * DRNN * 4, WS_TOT = WS_CL + (size_t)NB * 8 * SEQ * 4, WS_CTL = WS_TOT + (size_t)NB * 8 * NCHUNK * 4, WS_XH = WS_CTL + 16384, WS_END = WS_XH + (size_t)TOK * DM * 2;
constexpr int LDS_BYTES = 131072 + 4096;

DI float bf2f(bf16_t v) { return __uint_as_float((unsigned)v << 16); }
DI unsigned cvtpk(float lo, float hi) { f32x2_t v = {lo, hi}; bf16x2_t b = __builtin_convertvector(v, bf16x2_t); return __builtin_bit_cast(unsigned, b); }
DI float wave_sum(float v) {
#pragma unroll
    for (int o = 1; o < 64; o <<= 1) v += __shfl_xor(v, o);
    return v;
}
DI float wave_incl_scan(float v, int lane) {
#pragma unroll
    for (int o = 1; o < 64; o <<= 1) { const float t = __shfl_up(v, o); if (lane >= o) v += t; }
    return v;
}
DI float sigmoid_f(float x) { return __builtin_amdgcn_rcpf(1.0f + __builtin_amdgcn_exp2f(-1.4426950408889634f * x)); }
DI float gelu_tanh_f(float x) { const float u = 0.7978845608028654f * (x + 0.044715f * x * x * x); const float t = 1.0f - 2.0f * __builtin_amdgcn_rcpf(__builtin_amdgcn_exp2f(2.8853900817779268f * u) + 1.0f); return 0.5f * x * (1.0f + t); }
DI float neg_expm1_f(float t) {
    const float ser = -t * (1.0f + t * (0.5f + t * (0.16666667f + t * (0.041666668f + t * 0.0083333338f))));
    const float dir = 1.0f - __builtin_amdgcn_exp2f(1.4426950408889634f * t);
    return (t > -0.25f) ? ser : dir;
}

struct Args { const float* in[16]; float* out; unsigned char* ws; int ph_lo, ph_hi; };
struct Frame { LAS unsigned char* lds; int tid, lane, wave, vcu, G, bx, z; };

DI unsigned cvtpk_h(float lo, float hi) { typedef _Float16 h16x2 __attribute__((ext_vector_type(2))); const unsigned b = cvtpk(lo, hi);
    const h16x2 v = {(_Float16)__uint_as_float(b << 16), (_Float16)__uint_as_float(b & 0xffff0000u)}; return __builtin_bit_cast(unsigned, v); }
template <bool F16> DI void p0_item(const float* W, int K, int N, bf16_t* WT, int mode, const float* g, LAS float* scr, int item, int lane, int NP = 0) {
    if (NP == 0) NP = N;
    const int nblk = (NP + 31) >> 5, kb = item / nblk, nb = item - kb * nblk, k0 = 64 * kb, n0 = 32 * nb;
    const int n = n0 + (lane & 31);
    float wv[32];
    const float* wp = W + (size_t)(k0 + (lane >> 5)) * N + (n < N ? n : 0);
#pragma unroll
    for (int i = 0; i < 32; ++i) wv[i] = wp[(size_t)(2 * i) * N];
    if (g) {
#pragma unroll
        for (int i = 0; i < 32; ++i) wv[i] *= g[k0 + 2 * i + (lane >> 5)];
    }
#pragma unroll
    for (int i = 0; i < 32; ++i) scr[(2 * i + (lane >> 5)) * 33 + (lane & 31)] = (n < N) ? wv[i] : 0.f;
    LDS_WAIT();
    const int c = lane & 7;
#pragma unroll
    for (int j = 0; j < 4; ++j) { const int nn = (lane >> 3) + 8 * j; const LAS float* s = scr + (8 * c) * 33 + nn;
        u32x4 o;
        if constexpr (F16) { o.x = cvtpk_h(s[0 * 33], s[1 * 33]); o.y = cvtpk_h(s[2 * 33], s[3 * 33]); o.z = cvtpk_h(s[4 * 33], s[5 * 33]); o.w = cvtpk_h(s[6 * 33], s[7 * 33]); }
        else { o.x = cvtpk(s[0 * 33], s[1 * 33]); o.y = cvtpk(s[2 * 33], s[3 * 33]); o.z = cvtpk(s[4 * 33], s[5 * 33]); o.w = cvtpk(s[6 * 33], s[7 * 33]); }
        const int sn = n0 + nn; int dr = sn;
        if (mode == 1) { const int isb = sn >= DFF ? 1 : 0; const int jj = sn - isb * DFF; dr = 256 * (jj >> 7) + 128 * isb + (jj & 127); }
        const int x = dr & 127, y = x & 31, R = (x & ~31) + 16 * ((y >> 2) & 1) + 4 * (y >> 3) + (y & 3);
        const size_t blk = ((size_t)(dr >> 8) * (K >> 6) + (k0 >> 6)) * 2 + ((dr >> 7) & 1);
        *(u32x4*)((unsigned char*)WT + blk * 16384 + pg8::lds_byte(R, 8 * c)) = o; }
    LDS_WAIT();
}
DI void p0_prologue(const Frame& F, const Args& A, unsigned char* ws) {
#define in(i) (A.in[(i) + F.z])
    LAS float* scr = (LAS float*)(F.lds + F.wave * 16384);
    const int gw = F.vcu * 8 + F.wave, NGW = F.G * 8, lane = F.lane;
    const float* ffn_norm = in(1); const float* ffn_w_in = in(2); const float* ffn_w_out = in(3); const float* mix_norm = in(4); const float* hy_w_in = in(5);
    const float* hy_w_out = in(13); const float* sb_w_qkv = in(14); const float* sb_w_out = in(15);
    { constexpr int I = (DM / 64) * (2 * DFF / 32);
      for (int it = gw; it < 8 * I; it += NGW) { const int mi = it / I, r = it - mi * I; p0_item<true>(ffn_w_in + (size_t)mi * DM * 2 * DFF, DM, 2 * DFF, (bf16_t*)(ws + WS_WFI + mi * SZ_WFI), 1, ffn_norm + mi * DM, scr, r, lane); } }
    { constexpr int I = (DFF / 64) * (DM / 32);
      for (int it = gw; it < 8 * I; it += NGW) { const int mi = it / I, r = it - mi * I; p0_item<false>(ffn_w_out + (size_t)mi * DFF * DM, DFF, DM, (bf16_t*)(ws + WS_WFO + mi * SZ_WFO), 0, nullptr, scr, r, lane); } }
    { constexpr int I = (DM / 64) * (HYW / 32);
      for (int it = gw; it < 2 * I; it += NGW) { const int mi = it / I, r = it - mi * I; p0_item<true>(hy_w_in + (size_t)mi * DM * HYIN, DM, HYIN, (bf16_t*)(ws + WS_WHI + mi * SZ_WHI), 0, mix_norm + (2 * mi) * DM, scr, r, lane, HYW); } }
    { constexpr int I = (DM / 64) * (DM / 32);
      for (int it = gw; it < 2 * I; it += NGW) { const int mi = it / I, r = it - mi * I; p0_item<false>(hy_w_out + (size_t)mi * DM * DM, DM, DM, (bf16_t*)(ws + WS_WHO + mi * SZ_W1K), 0, nullptr, scr, r, lane); } }
    { constexpr int I = (DM / 64) * (SBW / 32);
      for (int it = gw; it < 2 * I; it += NGW) { const int mi = it / I, r = it - mi * I; p0_item<true>(sb_w_qkv + (size_t)mi * DM * SBW, DM, SBW, (bf16_t*)(ws + WS_WSQ + mi * SZ_WSQ), 0, mix_norm + (2 * mi + 1) * DM, scr, r, lane); } }
    { constexpr int I = (DM / 64) * (DM / 32);
      for (int it = gw; it < 2 * I; it += NGW) { const int mi = it / I, r = it - mi * I; p0_item<false>(sb_w_out + (size_t)mi * DM * DM, DM, DM, (bf16_t*)(ws + WS_WSO + mi * SZ_W1K), 0, nullptr, scr, r, lane); } }
    const float* x = in(0); float* SSQ = (float*)(ws + WS_SSQ);
    for (int m = gw; m < TOK; m += NGW) {
        const f32x4* xr = (const f32x4*)(x + (size_t)m * DM) + lane; f32x4 v[4]; float s = 0.f;
#pragma unroll
        for (int j = 0; j < 4; ++j) { v[j] = xr[64 * j]; s += (v[j][0] * v[j][0] + v[j][1] * v[j][1]) + (v[j][2] * v[j][2] + v[j][3] * v[j][3]); }
        s = wave_sum(s);
        typedef _Float16 h16x4 __attribute__((ext_vector_type(4)));
        unsigned long long* h8 = (unsigned long long*)((_Float16*)(ws + WS_XH) + (size_t)m * DM) + lane;
#pragma unroll
        for (int j = 0; j < 4; ++j) { const h16x4 hv = {(_Float16)v[j][0], (_Float16)v[j][1], (_Float16)v[j][2], (_Float16)v[j][3]}; h8[64 * j] = __builtin_bit_cast(unsigned long long, hv); }
        if (lane < 16) SSQ[(size_t)m * 16 + lane] = (lane == 0) ? s : 0.f;
    }
}

DI void rglru_passA(const Frame& F, const Args& A, int e, unsigned char* ws) {
    const bf16_t* PROJ = (const bf16_t*)(ws + WS_BIG);
    float* HL = (float*)(ws + WS_HL); float* PL = (float*)(ws + WS_PL); float* CA = (float*)(ws + WS_CA); float* CB = (float*)(ws + WS_CB);
    const int hb = F.vcu & 7, j = F.lane, w = F.wave, ch = hb * 64 + j, r32 = j & 31, hi = j >> 5;
    const float* cw = in(6) + (size_t)e * 4 * DRNN; const float* cbp = in(7) + (size_t)e * DRNN; const float* gw = in(8) + (size_t)e * 2 * 8 * 64 * 64;
    const float* gb = in(9) + (size_t)e * 2 * DRNN; const float* lam = in(10) + (size_t)e * DRNN;
    const int mt = w & 3, gate = w >> 2;
    bf16x8 bw[2][4];
#pragma unroll
    for (int th = 0; th < 2; ++th)
#pragma unroll
        for (int sft = 0; sft < 4; ++sft) { const float* p = gw + ((size_t)(gate * 8 + hb) * 64 + 16 * sft + 8 * hi) * 64 + 32 * th + r32;
            u32x4 q; q.x = cvtpk(p[0], p[64]); q.y = cvtpk(p[128], p[192]); q.z = cvtpk(p[256], p[320]); q.w = cvtpk(p[384], p[448]); bw[th][sft] = __builtin_bit_cast(bf16x8, q); }
    const float cw0 = cw[0 * DRNN + ch], cw1 = cw[1 * DRNN + ch], cw2 = cw[2 * DRNN + ch], cw3 = cw[3 * DRNN + ch], cb0 = cbp[ch];
    const float br = gb[ch], bi = gb[DRNN + ch];
    const float sp8 = -8.0f * log1pf(expf(-lam[ch]));
    constexpr int XCB_PITCH = 144, G_PITCH = 132;
    LAS float* xcs = (LAS float*)(F.lds); LAS unsigned char* xcb = F.lds + 32768; LAS float* G = (LAS float*)(F.lds + 51200);
    LAS float* gA = (LAS float*)(F.lds + 118784); LAS float* gB = (LAS float*)(F.lds + 118784 + 2048);
    for (int idx = F.vcu >> 3; idx < NB * NCHUNK; idx += (F.G >> 3)) {
        const int b = idx / NCHUNK, c = idx - b * NCHUNK; const int s0 = c * 128 + 16 * w; const size_t row0 = (size_t)b * SEQ + s0;
        float u0, u1, u2;
        u0 = (s0 >= 3) ? bf2f(PROJ[(row0 - 3) * HYW + ch]) : 0.f; u1 = (s0 >= 2) ? bf2f(PROJ[(row0 - 2) * HYW + ch]) : 0.f; u2 = (s0 >= 1) ? bf2f(PROJ[(row0 - 1) * HYW + ch]) : 0.f;
        float uv[16];
#pragma unroll
        for (int t = 0; t < 16; ++t) uv[t] = bf2f(PROJ[(row0 + t) * HYW + ch]);
#pragma unroll
        for (int t = 0; t < 16; ++t) { const float u3 = uv[t]; const float xc = cb0 + cw0 * u0 + cw1 * u1 + cw2 * u2 + cw3 * u3;
            xcs[(16 * w + t) * 64 + j] = xc; *(LAS bf16_t*)(xcb + (16 * w + t) * XCB_PITCH + 2 * j) = (bf16_t)(cvtpk(xc, xc) & 0xffffu); u0 = u1; u1 = u2; u2 = u3; }
        LDS_WAIT(); __syncthreads();
        {
            f32x16 acc0, acc1;
#pragma unroll
            for (int r = 0; r < 16; ++r) { acc0[r] = 0.f; acc1[r] = 0.f; }
            bf16x8 af[4];
#pragma unroll
            for (int sft = 0; sft < 4; ++sft) af[sft] = *(const LAS bf16x8*)(xcb + (32 * mt + r32) * XCB_PITCH + (16 * sft + 8 * hi) * 2);
#pragma unroll
            for (int sft = 0; sft < 4; ++sft) { acc0 = MFMA32(af[sft], bw[0][sft], acc0); acc1 = MFMA32(af[sft], bw[1][sft], acc1); }
#pragma unroll
            for (int r = 0; r < 16; ++r) { const int tok = 32 * mt + (r & 3) + 8 * (r >> 2) + 4 * hi;
                G[tok * G_PITCH + gate * 64 + r32] = acc0[r]; G[tok * G_PITCH + gate * 64 + 32 + r32] = acc1[r]; }
        }
        LDS_WAIT(); __syncthreads();
        float h = 0.f, P = 1.f;
#pragma unroll 4
        for (int t = 0; t < 16; ++t) {
            LAS float* gp = G + (16 * w + t) * G_PITCH + j;
            const float r = sigmoid_f(gp[0] + br), ig = sigmoid_f(gp[64] + bi);
            const float la = sp8 * r, a = __builtin_amdgcn_exp2f(1.4426950408889634f * la), bb = __builtin_amdgcn_sqrtf(neg_expm1_f(2.0f * la)) * ig * xcs[(16 * w + t) * 64 + j];
            h = a * h + bb; P = a * P;
            gp[0] = h; gp[64] = P;
        }
        gA[w * 64 + j] = P; gB[w * 64 + j] = h;
        LDS_WAIT(); __syncthreads();
        float Hin = 0.f, Pin = 1.f;
        for (int w2 = 0; w2 < w; ++w2) { const float a = gA[w2 * 64 + j], bq = gB[w2 * 64 + j]; Hin = a * Hin + bq; Pin *= a; }
        float hv = 0.f, pv = 1.f;
#pragma unroll 4
        for (int t = 0; t < 16; ++t) { const float hl = G[(16 * w + t) * G_PITCH + j], pl = G[(16 * w + t) * G_PITCH + 64 + j]; hv = hl + pl * Hin; pv = pl * Pin;
            HL[(row0 + t) * DRNN + ch] = hv; PL[(row0 + t) * DRNN + ch] = pv; }
        if (w == 7) { CA[((size_t)b * NCHUNK + c) * DRNN + ch] = pv; CB[((size_t)b * NCHUNK + c) * DRNN + ch] = hv; }
        LDS_WAIT(); __syncthreads();
    }
}
DI void hy_prep(const Frame& F, const Args& A, int e, unsigned char* ws) {
    bf16_t* PROJ = (bf16_t*)(ws + WS_BIG); float* CL = (float*)(ws + WS_CL); float* TOT = (float*)(ws + WS_TOT);
    const float* fb = in(11) + (size_t)e * 8; const float* qkg = in(12) + (size_t)e * 2 * 64;
    const int tid = F.tid, sub = tid & 7;
    for (int idx = F.vcu; idx < NB * NCHUNK; idx += F.G) {
        const int b = idx / NCHUNK, c = idx - b * NCHUNK; const size_t row0 = (size_t)b * SEQ + c * 128;
        for (int it0 = 0; it0 < 32; it0 += 8) { u32x4 rawv[8];
#pragma unroll
          for (int ii = 0; ii < 8; ++ii) { const int rid = (it0 + ii) * 64 + (tid >> 3); rawv[ii] = *(const u32x4*)(PROJ + (row0 + (rid >> 4)) * HYW + 1024 + (rid & 15) * 64 + sub * 8); }
#pragma unroll
          for (int ii = 0; ii < 8; ++ii) { const int it = it0 + ii;
            const int rid = it * 64 + (tid >> 3), tok = rid >> 4, hq = rid & 15;
            bf16_t* p = PROJ + (row0 + tok) * HYW + 1024 + hq * 64 + sub * 8;
            const u32x4 raw = rawv[ii]; float v[8];
#pragma unroll
            for (int i = 0; i < 4; ++i) { v[2 * i] = __uint_as_float(raw[i] << 16); v[2 * i + 1] = __uint_as_float(raw[i] & 0xffff0000u); }
            float ss = 0.f;
#pragma unroll
            for (int i = 0; i < 8; ++i) ss += v[i] * v[i];
            ss += __shfl_xor(ss, 1); ss += __shfl_xor(ss, 2); ss += __shfl_xor(ss, 4);
            const float inv = __builtin_amdgcn_rsqf(ss * (1.0f / 64.0f) + 1e-6f) * (hq < 8 ? QSC : 1.0f);
            const float* g = qkg + (hq >> 3) * 64 + sub * 8;
            u32x4 o; o.x = cvtpk(v[0] * inv * g[0], v[1] * inv * g[1]); o.y = cvtpk(v[2] * inv * g[2], v[3] * inv * g[3]);
            o.z = cvtpk(v[4] * inv * g[4], v[5] * inv * g[5]); o.w = cvtpk(v[6] * inv * g[6], v[7] * inv * g[7]);
            *(u32x4*)p = o;
          } }
        { const int h = F.wave, l = F.lane; const float fbh = fb[h];
          const float x0 = bf2f(PROJ[(row0 + 2 * l) * HYW + 2560 + h]) + fbh, x1 = bf2f(PROJ[(row0 + 2 * l + 1) * HYW + 2560 + h]) + fbh;
          const float l0 = fminf(x0, 0.f) - log1pf(expf(-fabsf(x0))), l1 = fminf(x1, 0.f) - log1pf(expf(-fabsf(x1)));
          const float incl = wave_incl_scan(l0 + l1, l);
          float* cl = CL + ((size_t)b * 8 + h) * SEQ + c * 128 + 2 * l; cl[0] = incl - l1; cl[1] = incl;
          if (l == 63) TOT[((size_t)b * 8 + h) * NCHUNK + c] = incl; }
    }
}
DI void rglru_passC(const Frame& F, unsigned char* ws) {
    const bf16_t* PROJ = (const bf16_t*)(ws + WS_BIG); bf16_t* YB = (bf16_t*)(ws + WS_YB);
    const float* HL = (const float*)(ws + WS_HL); const float* PL = (const float*)(ws + WS_PL); const float* CA = (const float*)(ws + WS_CA); const float* CB = (const float*)(ws + WS_CB);
    const int c4 = (F.tid & 127) * 4, tq = F.tid >> 7;
    for (int idx = F.vcu; idx < NB * NCHUNK; idx += F.G) {
        const int b = idx / NCHUNK, c = idx - b * NCHUNK; const size_t row0 = (size_t)b * SEQ + c * 128 + tq * 32;
        f32x4 Hin = {0.f, 0.f, 0.f, 0.f};
        const f32x4* ca = (const f32x4*)(CA + (size_t)b * NCHUNK * DRNN + c4); const f32x4* cb = (const f32x4*)(CB + (size_t)b * NCHUNK * DRNN + c4);
        int c2 = 0;
        for (; c2 + 8 <= c; c2 += 8) { f32x4 av[8], bv[8];
#pragma unroll
            for (int i = 0; i < 8; ++i) { av[i] = ca[(size_t)(c2 + i) * (DRNN / 4)]; bv[i] = cb[(size_t)(c2 + i) * (DRNN / 4)]; }
#pragma unroll
            for (int i = 0; i < 8; ++i) Hin = av[i] * Hin + bv[i]; }
        for (; c2 < c; ++c2) Hin = ca[(size_t)c2 * (DRNN / 4)] * Hin + cb[(size_t)c2 * (DRNN / 4)];
        for (int t0 = 0; t0 < 32; t0 += 8) { f32x4 hv[8], pv[8]; unsigned long long gv[8];
#pragma unroll
            for (int i = 0; i < 8; ++i) { const size_t row = row0 + t0 + i; hv[i] = *(const f32x4*)(HL + row * DRNN + c4); pv[i] = *(const f32x4*)(PL + row * DRNN + c4); gv[i] = *(const unsigned long long*)(PROJ + row * HYW + 512 + c4); }
#pragma unroll
            for (int i = 0; i < 8; ++i) { const size_t row = row0 + t0 + i; const f32x4 hh = hv[i] + pv[i] * Hin;
                const float g0 = __uint_as_float((unsigned)(gv[i] & 0xffffull) << 16), g1 = __uint_as_float((unsigned)(gv[i] & 0xffff0000ull)), g2 = __uint_as_float((unsigned)((gv[i] >> 32) & 0xffffull) << 16), g3 = __uint_as_float((unsigned)((gv[i] >> 32) & 0xffff0000ull));
                const unsigned long long o = (unsigned long long)cvtpk(hh[0] * gelu_tanh_f(g0), hh[1] * gelu_tanh_f(g1)) | ((unsigned long long)cvtpk(hh[2] * gelu_tanh_f(g2), hh[3] * gelu_tanh_f(g3)) << 32);
                *(unsigned long long*)(YB + row * DM + c4) = o; } }
    }
}
constexpr int A_K = 0, A_V = 16384, A_WSF = 32768, A_PRE = A_WSF + 2048, A_FLG = A_PRE + 256, A_CBUF = 36864, A_OST = 69632;
DI int crow(int r, int hi) { return (r & 3) + 8 * (r >> 2) + 4 * hi; }
DI int pislot(int rho) { const int rp = rho & 31; return (rho & 32) + 16 * ((rp >> 2) & 1) + 4 * (rp >> 3) + (rp & 3); }
DI s16x4 vtr(const LAS unsigned char* p) { typedef short v4i16_t __attribute__((ext_vector_type(4))); return __builtin_bit_cast(s16x4, __builtin_amdgcn_ds_read_tr16_b64_v4i16((LAS v4i16_t*)p)); }
DI bf16x8 pack8(const f32x16& c, int s) { u32x4 p; p.x = cvtpk(c[8 * s], c[8 * s + 1]); p.y = cvtpk(c[8 * s + 2], c[8 * s + 3]); p.z = cvtpk(c[8 * s + 4], c[8 * s + 5]); p.w = cvtpk(c[8 * s + 6], c[8 * s + 7]); return __builtin_bit_cast(bf16x8, p); }
DI void sb_sub(f32x16& c, float& carry, int keybase, int qidx, bool band, int hi) {
    f32x16 nb;
#pragma unroll
    for (int r = 0; r < 16; ++r) { const float e = __builtin_amdgcn_exp2f(c[r]); nb[r] = __builtin_amdgcn_rcpf(1.0f + e); c[r] = 1.0f - nb[r]; }
    if (band) {
#pragma unroll
        for (int r = 0; r < 16; ++r) if (keybase + r >= qidx) { nb[r] = 1.0f; c[r] = 0.f; }
    }
    float s = 1.0f;
#pragma unroll
    for (int r = 15; r >= 0; --r) { const float beta = c[r]; c[r] = beta * s; s = s * nb[r]; }
    const float other = __shfl_xor(s, 32);
    const float factor = carry * (hi ? 1.0f : other);
#pragma unroll
    for (int r = 0; r < 16; ++r) c[r] *= factor;
    carry = carry * (s * other);
}
template <int MODE>
DI void attn_unit(int b, int h, int qb, const bf16_t* Qp, const bf16_t* Kp, const bf16_t* Vp, int pitch, bf16_t* Op, const float* CL, const float* TOT, int nh, LAS unsigned char* lds, const int tid) {
    const int lane = tid & 63, r32 = lane & 31, hi = lane >> 5; const int wid = __builtin_amdgcn_readfirstlane(tid >> 6);
    const size_t rowbase = (size_t)b * SEQ; const int q0 = qb * 256;
    const bf16_t* Qw = Qp + (rowbase + q0 + wid * 32) * pitch + h * 64;
    const bf16_t* Kh = Kp + rowbase * pitch + h * 64; const bf16_t* Vh = Vp + rowbase * pitch + h * 64;
    LAS float* wsf = (LAS float*)(lds + A_WSF) + wid * 64; LAS float* cbuf = (LAS float*)(lds + A_CBUF); LAS float* pre = (LAS float*)(lds + A_PRE);
    const int kslot = lane, vslot = 16 * (wid & 3) + (lane >> 2);
    const int kkey = MODE ? pislot(kslot) : kslot, vkey = MODE ? pislot(vslot) : vslot;
    const bf16_t* ksrc = Kh + (size_t)kkey * pitch + wid * 8; const bf16_t* vsrc = Vh + (size_t)vkey * pitch + (wid >> 2) * 32 + (lane & 3) * 8;
    const unsigned stoff = wid * 1024 + lane * 16;
    const int NT = (q0 + 256) / 64; const int qidx = q0 + wid * 32 + r32;
    f32x16 cinit;
#pragma unroll
    for (int r = 0; r < 16; ++r) cinit[r] = 0.f;
    if (MODE == 0) {
        if (wid == 0) { const float tv = TOT[((size_t)b * nh + h) * NCHUNK + lane]; const float inc = wave_incl_scan(tv, lane); pre[lane] = inc - tv; }
        LDS_WAIT(); __syncthreads();
        const float* cl = CL + ((size_t)b * nh + h) * SEQ;
        for (int jx = tid; jx < q0 + 256; jx += 512) cbuf[jx] = (cl[jx] + pre[jx >> 7]) * LOG2E;
        LDS_WAIT(); __syncthreads();
        const float cq = cbuf[qidx];
#pragma unroll
        for (int r = 0; r < 16; ++r) cinit[r] = cq;
    }
    bf16x8 qr[4];
#pragma unroll
    for (int d0 = 0; d0 < 4; ++d0) qr[d0] = *(const bf16x8*)(Qw + (size_t)r32 * pitch + d0 * 16 + hi * 8);
    f32x16 o[2];
#pragma unroll
    for (int r = 0; r < 16; ++r) { o[0][r] = 0.f; o[1][r] = 0.f; }
    float mrun = -INFINITY, lrun = 0.f, carry = 1.0f;
    u32x4 kreg, vreg;
    { const int t = MODE ? NT - 1 : 0; kreg = *(const u32x4*)(ksrc + (size_t)t * 64 * pitch); vreg = *(const u32x4*)(vsrc + (size_t)t * 64 * pitch); }
    *(LAS u32x4*)(lds + A_K + stoff) = kreg; *(LAS u32x4*)(lds + A_V + stoff) = vreg;
    LDS_WAIT(); __syncthreads();
    LAS unsigned* flg = (LAS unsigned*)(lds + A_FLG); bool walive = true;
    for (int it = 0; it < NT; ++it) {
        const int t = MODE ? NT - 1 - it : it; const unsigned boff = (it & 1) * 8192u;
        if (MODE == 1 && it > 0) {
            const u32x4 fa = *(const LAS u32x4*)(flg + ((it - 1) & 1) * 8), fb = *(const LAS u32x4*)(flg + ((it - 1) & 1) * 8 + 4);
            if (((fa.x | fa.y) | (fa.z | fa.w) | (fb.x | fb.y) | (fb.z | fb.w)) == 0u) break;
        }
        if (it + 1 < NT) { const int tn = MODE ? t - 1 : t + 1; kreg = *(const u32x4*)(ksrc + (size_t)tn * 64 * pitch); vreg = *(const u32x4*)(vsrc + (size_t)tn * 64 * pitch); }
        const bool live = (t * 64 < q0 + wid * 32 + 32) && (MODE == 0 || walive);
        if (live) {
        f32x16 c0 = cinit, c1 = cinit;
        { const LAS unsigned char* kb = lds + A_K + boff + hi * 1024 + r32 * 16;
          bf16x8 kf[8];
#pragma unroll
          for (int d0 = 0; d0 < 4; ++d0) { kf[2 * d0] = *(const LAS bf16x8*)(kb + d0 * 2048); kf[2 * d0 + 1] = *(const LAS bf16x8*)(kb + d0 * 2048 + 512); }
          __builtin_amdgcn_sched_barrier(0);
#pragma unroll
          for (int d0 = 0; d0 < 4; ++d0) { c0 = MFMA32(kf[2 * d0], qr[d0], c0); c1 = MFMA32(kf[2 * d0 + 1], qr[d0], c1); }
          __builtin_amdgcn_sched_barrier(0); }
        const bool band = (t * 64 + 63 >= q0 + wid * 32);
        if (MODE == 0) {
            const LAS f32x4* cb4 = (const LAS f32x4*)(cbuf + t * 64 + 4 * hi);
#pragma unroll
            for (int g = 0; g < 4; ++g) { const f32x4 b0 = cb4[2 * g], b1 = cb4[2 * g + 8];
#pragma unroll
                for (int i = 0; i < 4; ++i) { c0[4 * g + i] -= b0[i]; c1[4 * g + i] -= b1[i]; } }
            if (band) {
#pragma unroll
                for (int r = 0; r < 16; ++r) { const int key = t * 64 + crow(r, hi); if (key > qidx) c0[r] = -INFINITY; if (key + 32 > qidx) c1[r] = -INFINITY; }
            }
            float rm = fmaxf(c0[0], c1[0]);
#pragma unroll
            for (int r = 1; r < 16; ++r) rm = fmaxf(rm, fmaxf(c0[r], c1[r]));
            rm = fmaxf(rm, __shfl_xor(rm, 32));
            const float mnew = fmaxf(mrun, rm), f = __builtin_amdgcn_exp2f(mrun - mnew); mrun = mnew;
            float ps = 0.f;
#pragma unroll
            for (int r = 0; r < 16; ++r) { c0[r] = __builtin_amdgcn_exp2f(c0[r] - mnew); c1[r] = __builtin_amdgcn_exp2f(c1[r] - mnew); ps += c0[r] + c1[r]; }
            lrun = lrun * f + ps;
            if (hi == 0) wsf[r32] = f;
            LDS_WAIT();
#pragma unroll
            for (int g = 0; g < 4; ++g) { const f32x4 fv = *(const LAS f32x4*)(wsf + 8 * g + 4 * hi);
#pragma unroll
                for (int i = 0; i < 4; ++i) { o[0][4 * g + i] *= fv[i]; o[1][4 * g + i] *= fv[i]; } }
        } else {
            sb_sub(c1, carry, t * 64 + 32 + 16 * hi, qidx, band, hi);
            sb_sub(c0, carry, t * 64 + 16 * hi, qidx, band, hi);
        }
        const bf16x8 pa0 = pack8(c0, 0), pa1 = pack8(c0, 1), pa2 = pack8(c1, 0), pa3 = pack8(c1, 1);
        { const LAS unsigned char* vb = lds + A_V + boff + ((lane >> 4) & 1) * 32 + (lane & 3) * 8 + (4 * hi + ((lane & 15) >> 2)) * 64;
          bf16x8 vf[8];
#pragma unroll
          for (int i_ = 0; i_ < 8; ++i_) vf[i_] = __builtin_shufflevector(vtr(vb + (i_ >> 2) * 4096 + (i_ & 3) * 1024), vtr(vb + (i_ >> 2) * 4096 + (i_ & 3) * 1024 + 512), 0, 1, 2, 3, 4, 5, 6, 7);
          __builtin_amdgcn_sched_barrier(0);
#pragma unroll
          for (int d0 = 0; d0 < 2; ++d0) { o[d0] = MFMA32(pa0, vf[4 * d0], o[d0]); o[d0] = MFMA32(pa1, vf[4 * d0 + 1], o[d0]); o[d0] = MFMA32(pa2, vf[4 * d0 + 2], o[d0]); o[d0] = MFMA32(pa3, vf[4 * d0 + 3], o[d0]); }
          __builtin_amdgcn_sched_barrier(0); }
        }
        if (MODE == 1) { walive = __builtin_amdgcn_ballot_w64(carry > 9.094947017729282e-13f) != 0ull; if (lane == 0) flg[(it & 1) * 8 + wid] = walive ? 1u : 0u; }
        if (it + 1 < NT) { *(LAS u32x4*)(lds + A_K + (boff ^ 8192u) + stoff) = kreg; *(LAS u32x4*)(lds + A_V + (boff ^ 8192u) + stoff) = vreg; }
        LDS_WAIT(); __syncthreads();
    }
    f32x16 linv;
#pragma unroll
    for (int r = 0; r < 16; ++r) linv[r] = 1.0f;
    if (MODE == 0) {
        lrun += __shfl_xor(lrun, 32);
        if (hi == 0) wsf[r32] = lrun;
        LDS_WAIT();
#pragma unroll
        for (int g = 0; g < 4; ++g) { const f32x4 lv = *(const LAS f32x4*)(wsf + 8 * g + 4 * hi);
#pragma unroll
            for (int i = 0; i < 4; ++i) linv[4 * g + i] = 1.0f / lv[i]; }
    }
    { bf16_t* Ow = Op + (rowbase + q0 + wid * 32) * DM + h * 64;
      LAS bf16_t* stg = (LAS bf16_t*)(lds + A_OST) + wid * 2048;
#pragma unroll
      for (int r = 0; r < 16; ++r) { const int orow = crow(r, hi);
#pragma unroll
          for (int d0 = 0; d0 < 2; ++d0) { const float v = o[d0][r] * linv[r]; stg[orow * 64 + d0 * 32 + r32] = (bf16_t)(cvtpk(v, v) & 0xffffu); } }
      LDS_WAIT();
#pragma unroll
      for (int i = 0; i < 4; ++i) { const u32x4 v = *(const LAS u32x4*)(stg + lane * 8 + i * 512); *(u32x4*)(Ow + (size_t)(lane >> 3) * DM + (lane & 7) * 8 + (size_t)i * 8 * DM) = v; } }
    LDS_WAIT(); __syncthreads();
}

DI void fox_unit(int b, int h, int qb, const bf16_t* Qp, const bf16_t* Kp, const bf16_t* Vp, int pitch, bf16_t* Op, const float* CL, const float* TOT, float G2, LAS unsigned char* lds, const int tid) {
    const int lane = tid & 63, r32 = lane & 31, hi = lane >> 5; const int wid = __builtin_amdgcn_readfirstlane(tid >> 6);
    const size_t rowbase = (size_t)b * SEQ; const int q0 = qb * 256;
    const bf16_t* Qw = Qp + (rowbase + q0 + wid * 32) * pitch + h * 64;
    const bf16_t* Kh = Kp + rowbase * pitch + h * 64; const bf16_t* Vh = Vp + rowbase * pitch + h * 64;
    LAS float* wsf = (LAS float*)(lds + A_WSF) + wid * 64; LAS float* cbuf = (LAS float*)(lds + A_CBUF); LAS float* pre = (LAS float*)(lds + A_PRE);
    const bf16_t* ksrc = Kh + (size_t)lane * pitch + wid * 8; const bf16_t* vsrc = Vh + (size_t)(16 * (wid & 3) + (lane >> 2)) * pitch + (wid >> 2) * 32 + (lane & 3) * 8;
    const unsigned stoff = wid * 1024 + lane * 16;
    const int NT = (q0 + 256) / 64; const int qidx = q0 + wid * 32 + r32;
    if (wid == 0) { const float tv = TOT[((size_t)b * 8 + h) * NCHUNK + lane]; const float inc = wave_incl_scan(tv, lane); pre[lane] = inc - tv; }
    LDS_WAIT(); __syncthreads();
    const float* cl = CL + ((size_t)b * 8 + h) * SEQ;
    const float cref = (cl[q0] + pre[q0 >> 7]) * LOG2E;
    int dead = 0;
    const float SH = fminf(60.0f, fmaxf(0.0f, 120.0f - 2.0f * G2));
    if (tid < NT) { const int jn = 64 * tid + 63; dead = (cref - (cl[jn] + pre[jn >> 7]) * LOG2E < -160.0f + SH) ? 1 : 0; }
    const int tmin = __syncthreads_count(dead);
    const int nt = NT - tmin;
    for (int jx = 64 * tmin + tid; jx < q0 + 256; jx += 512) cbuf[jx] = (cl[jx] + pre[jx >> 7]) * LOG2E;
    bf16x8 qr[4];
#pragma unroll
    for (int d0 = 0; d0 < 4; ++d0) qr[d0] = *(const bf16x8*)(Qw + (size_t)r32 * pitch + d0 * 16 + hi * 8);
    u32x4 kreg, vreg;
    kreg = *(const u32x4*)(ksrc + (size_t)(NT - 1) * 64 * pitch); *(LAS u32x4*)(lds + A_K + stoff) = kreg;
    if (nt > 1) { kreg = *(const u32x4*)(ksrc + (size_t)(NT - 2) * 64 * pitch); *(LAS u32x4*)(lds + A_K + 8192 + stoff) = kreg; }
    LDS_WAIT(); __syncthreads();
    f32x16 cinit; { const float cq = cbuf[qidx] - G2 - SH;
#pragma unroll
      for (int r = 0; r < 16; ++r) cinit[r] = cq; }
    f32x16 o[2];
#pragma unroll
    for (int r = 0; r < 16; ++r) { o[0][r] = 0.f; o[1][r] = 0.f; }
    float lrun = 0.f;
    const int wq1 = q0 + wid * 32 + 32;
    f32x16 c0 = cinit, c1 = cinit, n0 = cinit, n1 = cinit;
    bf16x8 pa0 = {0, 0, 0, 0, 0, 0, 0, 0}, pa1 = pa0, pa2 = pa0, pa3 = pa0;
    bool lv_prev = false;
#define FOX_QK(C0, C1, BUF) do { const LAS unsigned char* kb_ = lds + A_K + (BUF) * 8192 + hi * 1024 + r32 * 16; bf16x8 kf_[8]; \
        _Pragma("unroll") for (int d0 = 0; d0 < 4; ++d0) { kf_[2 * d0] = *(const LAS bf16x8*)(kb_ + d0 * 2048); kf_[2 * d0 + 1] = *(const LAS bf16x8*)(kb_ + d0 * 2048 + 512); } \
        __builtin_amdgcn_sched_barrier(0);     \
        C0 = MFMA32(kf_[0], qr[0], cinit); C1 = MFMA32(kf_[1], qr[0], cinit);     \
        _Pragma("unroll") for (int d0 = 1; d0 < 4; ++d0) { C0 = MFMA32(kf_[2 * d0], qr[d0], C0); C1 = MFMA32(kf_[2 * d0 + 1], qr[d0], C1); } \
        __builtin_amdgcn_sched_barrier(0); } while (0)
#define FOX_PV(BUF) do { const LAS unsigned char* vb_ = lds + A_V + (BUF) * 8192 + ((lane >> 4) & 1) * 32 + (lane & 3) * 8 + (4 * hi + ((lane & 15) >> 2)) * 64; \
        bf16x8 vf_[8]; \
        _Pragma("unroll") for (int i_ = 0; i_ < 8; ++i_) vf_[i_] = __builtin_shufflevector(vtr(vb_ + (i_ >> 2) * 4096 + (i_ & 3) * 1024), vtr(vb_ + (i_ >> 2) * 4096 + (i_ & 3) * 1024 + 512), 0, 1, 2, 3, 4, 5, 6, 7); \
        __builtin_amdgcn_sched_barrier(0); \
        _Pragma("unroll") for (int d0 = 0; d0 < 2; ++d0) { \
            o[d0] = MFMA32(pa0, vf_[4 * d0], o[d0]); o[d0] = MFMA32(pa1, vf_[4 * d0 + 1], o[d0]); o[d0] = MFMA32(pa2, vf_[4 * d0 + 2], o[d0]); o[d0] = MFMA32(pa3, vf_[4 * d0 + 3], o[d0]); } \
        __builtin_amdgcn_sched_barrier(0); } while (0)
    if ((NT - 1) * 64 < wq1) FOX_QK(c0, c1, 0);
    LDS_WAIT(); __syncthreads();
#define FOX_ITER(IT, CU0, CU1, NX0, NX1) do { const int it_ = (IT); const int t = NT - 1 - it_; \
        if (it_ + 2 < nt) kreg = *(const u32x4*)(ksrc + (size_t)(t - 2) * 64 * pitch); \
        vreg = *(const u32x4*)(vsrc + (size_t)t * 64 * pitch); \
        const bool lv_cur = (t * 64 < wq1), lv_next = (it_ + 1 < nt) && ((t - 1) * 64 < wq1); \
        if (lv_next) FOX_QK(NX0, NX1, (it_ + 1) & 1); \
        if (lv_prev) FOX_PV((it_ - 1) & 1); \
        if (lv_cur) { \
            const LAS f32x4* cb4 = (const LAS f32x4*)(cbuf + t * 64 + 4 * hi); \
            _Pragma("unroll") for (int g = 0; g < 4; ++g) { const f32x4 b0 = cb4[2 * g], b1 = cb4[2 * g + 8]; \
                _Pragma("unroll") for (int i = 0; i < 4; ++i) { CU0[4 * g + i] -= b0[i]; CU1[4 * g + i] -= b1[i]; } } \
            if (t * 64 + 63 >= q0 + wid * 32) { \
                _Pragma("unroll") for (int r = 0; r < 16; ++r) { const int key = t * 64 + crow(r, hi); if (key > qidx) CU0[r] = -INFINITY; if (key + 32 > qidx) CU1[r] = -INFINITY; } \
            } \
            float ps = 0.f; \
            _Pragma("unroll") for (int r = 0; r < 16; ++r) { CU0[r] = __builtin_amdgcn_exp2f(CU0[r]); CU1[r] = __builtin_amdgcn_exp2f(CU1[r]); ps += CU0[r] + CU1[r]; } \
            lrun += ps; \
            pa0 = pack8(CU0, 0); pa1 = pack8(CU0, 1); pa2 = pack8(CU1, 0); pa3 = pack8(CU1, 1); \
        } \
        if (it_ + 2 < nt) *(LAS u32x4*)(lds + A_K + (it_ & 1) * 8192 + stoff) = kreg; \
        *(LAS u32x4*)(lds + A_V + (it_ & 1) * 8192 + stoff) = vreg; \
        LDS_WAIT(); __syncthreads(); \
        lv_prev = lv_cur; } while (0)
    for (int it = 0; it < nt; it += 2) { FOX_ITER(it, c0, c1, n0, n1); if (it + 1 < nt) FOX_ITER(it + 1, n0, n1, c0, c1); }
#undef FOX_ITER
    if (lv_prev) FOX_PV((nt - 1) & 1);
#undef FOX_QK
#undef FOX_PV
    lrun += __shfl_xor(lrun, 32);
    if (hi == 0) wsf[r32] = lrun;
    LDS_WAIT();
    f32x16 linv;
#pragma unroll
    for (int g = 0; g < 4; ++g) { const f32x4 lv = *(const LAS f32x4*)(wsf + 8 * g + 4 * hi);
#pragma unroll
        for (int i = 0; i < 4; ++i) linv[4 * g + i] = 1.0f / lv[i]; }
    { bf16_t* Ow = Op + (rowbase + q0 + wid * 32) * DM + h * 64;
      LAS bf16_t* stg = (LAS bf16_t*)(lds + A_OST) + wid * 2048;
#pragma unroll
      for (int r = 0; r < 16; ++r) { const int orow = crow(r, hi);
#pragma unroll
          for (int d0 = 0; d0 < 2; ++d0) { const float v = o[d0][r] * linv[r]; stg[orow * 64 + d0 * 32 + r32] = (bf16_t)(cvtpk(v, v) & 0xffffu); } }
      LDS_WAIT();
#pragma unroll
      for (int i = 0; i < 4; ++i) { const u32x4 v = *(const LAS u32x4*)(stg + lane * 8 + i * 512); *(u32x4*)(Ow + (size_t)(lane >> 3) * DM + (lane & 7) * 8 + (size_t)i * 8 * DM) = v; } }
    LDS_WAIT(); __syncthreads();
}
DI void fox_phase(const Frame& F, const bf16_t* Qp, const bf16_t* Kp, const bf16_t* Vp, int pitch, bf16_t* Op, const float* CL, const float* TOT, const float* qkg, unsigned* ctr) {
    float gq = 0.f, gk = 0.f;
    for (int i = 0; i < 64; ++i) { gq = fmaxf(gq, fabsf(qkg[i])); gk = fmaxf(gk, fabsf(qkg[64 + i])); }
    const float G2 = 64.0f * gq * gk * QSC * 1.02f + 0.5f;
    LAS int* uq = (LAS int*)(F.lds + A_FLG + 128);
    for (;;) {
        if (F.tid == 0) *uq = (int)__hip_atomic_fetch_add(ctr, 1u, __ATOMIC_RELAXED, __HIP_MEMORY_SCOPE_AGENT);
        LDS_WAIT(); __syncthreads();
        const int u = *uq;
        LDS_WAIT(); __syncthreads();
        if (u >= NB * 8 * 32) break;
        const int qb = 31 - (u >> 5), bh = u & 31;
        fox_unit(bh >> 3, bh & 7, qb, Qp, Kp, Vp, pitch, Op, CL, TOT, G2, F.lds, F.tid);
    }
}
template <int MODE> DI void attn_phase(const Frame& F, const bf16_t* Qp, const bf16_t* Kp, const bf16_t* Vp, int pitch, bf16_t* Op, const float* CL, const float* TOT, int nh, unsigned* ctr) {
    LAS int* uq = (LAS int*)(F.lds + A_FLG + 128);
    const int nunits = NB * nh * 32;
    for (;;) {
        if (F.tid == 0) *uq = (int)__hip_atomic_fetch_add(ctr, 1u, __ATOMIC_RELAXED, __HIP_MEMORY_SCOPE_AGENT);
        LDS_WAIT(); __syncthreads();
        const int u = *uq;
        LDS_WAIT(); __syncthreads();
        if (u >= nunits) break;
        const int nbh = NB * nh, qb = 31 - u / nbh, bh = u - (31 - qb) * nbh;
        attn_unit<MODE>(bh / nh, bh % nh, qb, Qp, Kp, Vp, pitch, Op, CL, TOT, nh, F.lds, F.tid);
    }
}

#define XB_TMO      128
#define XB_XCNT(j)  (256  + 64 * (j))
#define XB_XSUB(j)  (1280 + 64 * (j))
#define XB_XGEN(j)  (2304 + 64 * (j))
#define XB_TOP      3328
#define XB_TOPGEN   3392
#define XCD_BAR_WORDS 3456
#define XB_SPIN_CAP (1u << 18)

__device__ __forceinline__ unsigned xb_ld(unsigned* p)              { return __hip_atomic_load(p, __ATOMIC_RELAXED, __HIP_MEMORY_SCOPE_AGENT); }
__device__ __forceinline__ unsigned xb_add(unsigned* p, unsigned v) { return __hip_atomic_fetch_add(p, v, __ATOMIC_RELAXED, __HIP_MEMORY_SCOPE_AGENT); }
__device__ __forceinline__ unsigned xb_xcc_id() { return (unsigned)__builtin_amdgcn_s_getreg((3 << 11) | 20) & 0xFu; }
#define XB_SPIN(cond, bar) do { unsigned _sp = 0; while (cond) { __builtin_amdgcn_s_sleep(1); \
    if ((++_sp & 255u) == 0u) { if (xb_ld(&(bar)[XB_TMO])) break; if (_sp > XB_SPIN_CAP) { atomicAdd(&(bar)[XB_TMO], 1u); break; } } } } while (0)

struct XcdBarrier {
    unsigned* bar; unsigned x;
    volatile LAS unsigned* st;
};

__device__ __forceinline__ XcdBarrier xcd_barrier_post(unsigned* bar, volatile LAS unsigned* st) {
    XcdBarrier b; b.bar = bar; b.x = xb_xcc_id(); b.st = st;
    if (threadIdx.x == 0) (void)xb_add(&bar[XB_XCNT(b.x)], 1u);
    return b;
}
__device__ __forceinline__ void xcd_barrier_complete(unsigned* bar, unsigned x, unsigned& nloc, unsigned& nx) {
    const unsigned G = gridDim.x * gridDim.y * gridDim.z;
    unsigned sum, cnt, mine, sp = 0u;
    for (;;) {
        sum = 0u; cnt = 0u; mine = 0u;
#pragma unroll
        for (unsigned j = 0; j < 16; ++j) { const unsigned c = xb_ld(&bar[XB_XCNT(j)]); sum += c; cnt += (c > 0u) ? 1u : 0u; mine = (j == x) ? c : mine; }
        if (sum == G) break;
        __builtin_amdgcn_s_sleep(1);
        if ((++sp & 255u) == 0u) { if (xb_ld(&bar[XB_TMO])) break; if (sp > XB_SPIN_CAP) { atomicAdd(&bar[XB_TMO], 1u); break; } }
    }
    nloc = mine > 0u ? mine : 1u; nx = cnt > 0u ? cnt : 1u;
}

__device__ __forceinline__ void xcd_barrier(const XcdBarrier& b) {
    asm volatile("s_waitcnt vmcnt(0)" ::: "memory");
    __syncthreads();
    if (threadIdx.x == 0) {
        unsigned* bar = b.bar;
        __builtin_amdgcn_s_waitcnt(0);
        unsigned nloc = b.st[0], nx = b.st[1];
        if (nloc == 0u) { xcd_barrier_complete(bar, b.x, nloc, nx); b.st[0] = nloc; b.st[1] = nx; }
        const unsigned old = xb_add(&bar[XB_XSUB(b.x)], 1u);
        const unsigned gen = old / nloc;
        if (old + 1u == (gen + 1u) * nloc) {
            __builtin_amdgcn_fence(__ATOMIC_RELEASE, "agent");
            asm volatile("s_waitcnt vmcnt(0)" ::: "memory");
            const unsigned og = xb_add(&bar[XB_TOP], 1u);
            const unsigned tg = og / nx;
            if (og + 1u == (tg + 1u) * nx) xb_add(&bar[XB_TOPGEN], 1u);
            else XB_SPIN(xb_ld(&bar[XB_TOPGEN]) == tg, bar);
            __builtin_amdgcn_fence(__ATOMIC_ACQUIRE, "agent");
            xb_add(&bar[XB_XGEN(b.x)], 1u);
            asm volatile("s_waitcnt vmcnt(0)" ::: "memory");
        } else {
            XB_SPIN(xb_ld(&bar[XB_XGEN(b.x)]) == gen, bar);
            __builtin_amdgcn_fence(__ATOMIC_ACQUIRE, "agent");
            asm volatile("s_waitcnt vmcnt(0)" ::: "memory");
        }
    }
    __syncthreads();
}

constexpr int N_PHASES = 33;
__host__ __device__ inline bool phase_empty(int p) { if (p == 0) return false; const int L = (p - 1) >> 3, st = (p - 1) & 7; return (L & 1) && st == 3; }
__global__ void __launch_bounds__(512, 2) mk_fwd(Args a) {
    extern __shared__ __attribute__((aligned(16))) unsigned char lds_raw[];
    cg::grid_group grid = cg::this_grid();
    volatile LAS unsigned* bst = (volatile LAS unsigned*)((LAS unsigned char*)lds_raw + 131072 + 4032);
    if (threadIdx.x < 2) bst[threadIdx.x] = 0u;
    __syncthreads();
    XcdBarrier xbar = xcd_barrier_post((unsigned*)(a.ws + WS_CTL), bst);
    bool first_sync = true; bool redo = false; (void)redo;
    for (int p = a.ph_lo; p < a.ph_hi; ++p) {
        if (phase_empty(p)) continue;
        Frame F; F.lds = (LAS unsigned char*)lds_raw; { int t_ = threadIdx.x; asm volatile("" : "+v"(t_)); F.tid = t_; } F.lane = F.tid & 63; F.wave = __builtin_amdgcn_readfirstlane(F.tid >> 6);
        F.G = gridDim.x; { int bx = blockIdx.x; asm volatile("" : "+s"(bx)); F.bx = bx; F.vcu = (F.G % 8 == 0) ? (bx % 8) * (F.G / 8) + bx / 8 : bx; }
        { int z_ = 0; asm volatile("" : "+s"(z_)); F.z = z_; }
        unsigned char* ws = a.ws; asm volatile("" : "+s"(ws));
        const bf16_t* XB = (const bf16_t*)(ws + WS_XH); float* SSQ = (float*)(ws + WS_SSQ); bf16_t* BIG = (bf16_t*)(ws + WS_BIG); bf16_t* YB = (bf16_t*)(ws + WS_YB);
        if (p == 0) {
#ifndef NO_P0
            for (int rep_ = 0; rep_ < REP_P0; ++rep_) p0_prologue(F, a, ws);
#endif
        }
        else {
            const int L = (p - 1) >> 3, st = (p - 1) & 7, e = L >> 1; const bool hyb = !(L & 1);
            if (st == 0 || st == 6) {
                const int mi = L * 2 + (st == 6 ? 1 : 0);
                pg8::Gemm g{XB, (const bf16_t*)(ws + WS_WFI + mi * SZ_WFI), TOK, 2 * DFF, DM}; pg8::StaticOrder S; S.init(TOK, 2 * DFF, F.G, F.bx);
                pg8::EpiSwiglu E{BIG, DFF, SSQ};
                pg8::gemm_phase<pg8::EpiSwiglu, pg8::StaticOrder, true, true, true>(F.lds, g, S, E, F.tid);
            } else if (st == 1 || st == 7 || st == 5) {
                pg8::Gemm g; float* xo = a.out; asm volatile("" : "+s"(xo)); float alpha = 0.5f; if (p != N_PHASES - 1) xo = nullptr;
                if (st == 5) { g = pg8::Gemm{YB, (const bf16_t*)(ws + (hyb ? WS_WHO : WS_WSO) + e * SZ_W1K), TOK, DM, DM}; alpha = 1.0f; }
                else { const int mi = L * 2 + (st == 7 ? 1 : 0); g = pg8::Gemm{BIG, (const bf16_t*)(ws + WS_WFO + mi * SZ_WFO), TOK, DM, DFF}; }
                pg8::StaticOrder S; S.init(TOK, DM, F.G, F.bx);
                pg8::EpiRes E{xo, (_Float16*)(ws + WS_XH), SSQ, alpha};
                pg8::gemm_phase<pg8::EpiRes, pg8::StaticOrder, true, true>(F.lds, g, S, E, F.tid);
            } else if (st == 2) {
                const int N = hyb ? HYW : SBW;
                pg8::Gemm g{XB, (const bf16_t*)(ws + (hyb ? WS_WHI + e * SZ_WHI : WS_WSQ + e * SZ_WSQ)), TOK, N, DM}; pg8::StaticOrder S; S.init(TOK, N, F.G, F.bx);
                pg8::EpiProj E{BIG, N, SSQ, hyb ? 0 : 1024, QSC};
                pg8::gemm_phase<pg8::EpiProj, pg8::StaticOrder, true, true, true>(F.lds, g, S, E, F.tid);
            } else if (st == 3) {

#ifndef NO_PA
                for (int rep_ = 0; rep_ < REP_PA; ++rep_) rglru_passA(F, a, e, ws);
#endif
#ifndef NO_PREP
                if (!redo) hy_prep(F, a, e, ws);
#endif

            } else {

#ifndef NO_FOX
                if (hyb) { rglru_passC(F, ws); fox_phase(F, BIG + 1024, BIG + 1536, BIG + 2048, HYW, YB + 512, (const float*)(ws + WS_CL), (const float*)(ws + WS_TOT), a.in[12 + F.z] + (size_t)e * 128, (unsigned*)(ws + WS_CTL) + 3600 + 64 * e); }
#endif
#ifndef NO_SB
                if (!hyb) attn_phase<1>(F, BIG, BIG + 1024, BIG + 2048, SBW, YB, nullptr, nullptr, 16, (unsigned*)(ws + WS_CTL) + 3800 + 64 * e);
#endif

            }
        }
#if REP_F1 == 2
        { static_assert(true, ""); const int st_ = (p - 1) & 7; if (p > 0 && p < 9 && (st_ == REP_ST0 || st_ == REP_ST1)) { if (!redo) { redo = true; --p; } else redo = false; } }
#endif
        if (p + 1 < a.ph_hi) { if (first_sync) { grid.sync(); first_sync = false; } else xcd_barrier(xbar); }
    }
}

#ifndef REP_SB
#define REP_SB 1
#endif
#ifndef REP_FOX
#define REP_FOX 2
#endif
#ifndef MK_MULTI
#define MK_MULTI 0
#endif
extern "C" void kernel_launch(void* const* d_in, const int* in_sizes, int n_in, void* d_out, int out_size, void* d_ws, size_t ws_size, hipStream_t stream) {
    static int grid = 0;
    if (grid == 0) {
        if (n_in != 16 || in_sizes[0] != TOK * DM || out_size != TOK * DM || ws_size < WS_END) { fprintf(stderr, "kernel_launch: unexpected shapes / workspace (n_in %d, ws %zu, need %zu)\n", n_in, ws_size, (size_t)WS_END); grid = -1; return; }
        int dev = 0, cus = 0, per_cu = 0;
        hipGetDevice(&dev); hipDeviceGetAttribute(&cus, hipDeviceAttributeMultiprocessorCount, dev);
        if (hipFuncSetAttribute((const void*)mk_fwd, hipFuncAttributeMaxDynamicSharedMemorySize, LDS_BYTES) != hipSuccess) { fprintf(stderr, "kernel_launch: hipFuncSetAttribute failed\n"); grid = -1; return; }
        if (hipOccupancyMaxActiveBlocksPerMultiprocessor(&per_cu, (const void*)mk_fwd, 512, LDS_BYTES) != hipSuccess || per_cu < 1) { fprintf(stderr, "kernel_launch: occupancy query says %d\n", per_cu); per_cu = 1; }
        (void)hipGetLastError();
        grid = cus;
    }
    if (grid < 0) return;
    Args a{};
    if (hipMemsetAsync((char*)d_ws + WS_CTL, 0, 16384, stream) != hipSuccess) { fprintf(stderr, "kernel_launch: memset of the barrier words failed\n"); return; }
    for (int i = 0; i < 16; ++i) a.in[i] = (const float*)d_in[i];
    a.out = (float*)d_out; a.ws = (unsigned char*)d_ws;
#if MK_MULTI
    for (int p = 0; p < N_PHASES; ++p) { if (phase_empty(p)) continue; a.ph_lo = p; a.ph_hi = p + 1; hipLaunchKernelGGL(mk_fwd, dim3(grid), dim3(512), LDS_BYTES, stream, a); }
#else
    a.ph_lo = 0; a.ph_hi = N_PHASES;
    void* args[] = {&a};
    hipError_t e = hipLaunchCooperativeKernel((const void*)mk_fwd, dim3(grid), dim3(512), args, LDS_BYTES, stream);
    if (e != hipSuccess) fprintf(stderr, "cooperative launch failed: %s (grid %d)\n", hipGetErrorString(e), grid);
#endif
}
```

```cpp
#include <hip/hip_runtime.h>
#include <hip/hip_cooperative_groups.h>
#include <cstdio>
#include <cstdint>
namespace cg = cooperative_groups;
#define DI __device__ __forceinline__
#define REP_SB 1
#define REP_FOX 1
#define REP_SYNC 1
#define REP_P0 1
#define REP_PA 1
#define REP_F1 1
#define REP_ST0 1
#define REP_ST1 1
namespace pg8 {
#define PG8_LAS __attribute__((address_space(3)))
typedef unsigned short bf16_t;
typedef short bf16x8 __attribute__((ext_vector_type(8)));
typedef float f32x4 __attribute__((ext_vector_type(4)));
typedef unsigned u32x4 __attribute__((ext_vector_type(4)));
typedef _Float16 h16x8 __attribute__((ext_vector_type(8)));
constexpr int BM = 256, BK = 64, HALF = 128, HTB = HALF * BK * 2  , STAGE_BYTES = 8 * HTB, NXCD = 8, WGM = 8;

__host__ __device__ __forceinline__ int lds_byte(int r, int c) { const int st = (r >> 4) * 2 + (c >> 5), rr = r & 15, cc = c & 31, ob = rr * 64 + cc * 2; return st * 1024 + (ob ^ (((ob >> 9) & 1) << 5)); }
__host__ __device__ __forceinline__ void stage_rc(int b, int& R, int& C) { const int st = b / 1024, sb = b % 1024, swz = sb ^ (((sb >> 9) & 1) << 5); R = (st >> 1) * 16 + swz / 64; C = (st & 1) * 32 + (swz % 64) / 2; }
__host__ __device__ __forceinline__ int perm32(int rho) { const int n = rho >> 4, i = rho & 15; return 8 * (i >> 2) + 4 * n + (i & 3); }

struct Unit { int pm, pn; };
struct Gemm { const bf16_t* A; const bf16_t* Bt; int M, N, K; };

struct StaticOrder {
    int nM, nN, nwg, G, c;
    __host__ __device__ void init(int M, int N, int G_, int c_) { nM = M / BM; nN = N / BM; nwg = nM * nN; G = G_; c = c_; }
    __host__ __device__ bool next(int i, Unit& u) const {
        const long L = (long)i * G + c; if (L >= nwg) return false;
        int wgid = (int)L; { const int q = nwg / NXCD, r = nwg % NXCD, xcd = wgid % NXCD, off = wgid / NXCD; wgid = (xcd < r ? xcd * (q + 1) : r * (q + 1) + (xcd - r) * q) + off; }
        const int nig = WGM * nN, gid = wgid / nig, fm = gid * WGM, gsz = (nM - fm) < WGM ? (nM - fm) : WGM;
        u.pm = fm + ((wgid % nig) % gsz); u.pn = (wgid % nig) / gsz; return true;
    }
    __device__ __forceinline__ void a_ready(const Unit&) const {}
    __device__ __forceinline__ void done(const Unit&) const {}
};

__device__ __forceinline__ unsigned cvt_pk_bf16(float lo, float hi) { unsigned r; asm volatile("v_cvt_pk_bf16_f32 %0, %1, %2" : "=v"(r) : "v"(lo), "v"(hi)); return r; }
constexpr float RMS_EPS_F = 1e-6f;
#define PG8_GAS __attribute__((address_space(1)))
__device__ __forceinline__ float rowscale(const float* ssq, int row) {
    const PG8_GAS f32x4* p = (const PG8_GAS f32x4*)(ssq + (size_t)row * 16);
    const f32x4 a = p[0], b = p[1], c = p[2], d = p[3];
    const float s = ((a[0] + a[1]) + (a[2] + a[3])) + ((b[0] + b[1]) + (b[2] + b[3])) + ((c[0] + c[1]) + (c[2] + c[3])) + ((d[0] + d[1]) + (d[2] + d[3]));
    return __builtin_amdgcn_rsqf(s * (1.0f / 1024.0f) + RMS_EPS_F);
}
__device__ __forceinline__ float silu_f(float a) { return a * __builtin_amdgcn_rcpf(1.0f + __builtin_amdgcn_exp2f(-1.4426950408889634f * a)); }
struct EpiSwiglu {
    static constexpr bool PERM = true, AFTER_DRAIN = false;
    bf16_t* H; int ldh; const float* ssq;
    __device__ __forceinline__ void operator()(const f32x4 (&acc)[2][2][4][2], const Unit& u, int wr, int wc, int fr, int fq) const {
        const int row0 = u.pm * BM + wr * 64 + fr, col0 = u.pn * HALF + wc * 32 + 8 * fq;
        float rs[2][4];
        { const int l64 = fr + 16 * fq; float rsl[2];
#pragma unroll
          for (int ai = 0; ai < 2; ++ai) rsl[ai] = rowscale(ssq, u.pm * BM + ai * HALF + wr * 64 + l64);
#pragma unroll
          for (int ai = 0; ai < 2; ++ai)
#pragma unroll
              for (int m = 0; m < 4; ++m) rs[ai][m] = __shfl(rsl[ai], m * 16 + fr); }
#pragma unroll
        for (int ai = 0; ai < 2; ++ai)
#pragma unroll
            for (int m = 0; m < 4; ++m) { const int row = row0 + ai * HALF + m * 16; const float r_ = rs[ai][m];
                typedef float f32x2v __attribute__((ext_vector_type(2)));
                const float k_ = -1.4426950408889634f * r_, r2_ = r_ * r_;
                unsigned wq[4];
#pragma unroll
                for (int q = 0; q < 4; ++q) { const f32x4 av = acc[ai][0][m][q >> 1], bv = acc[ai][1][m][q >> 1];
                    const f32x2v a2 = {av[2 * (q & 1)], av[2 * (q & 1) + 1]}, b2 = {bv[2 * (q & 1)], bv[2 * (q & 1) + 1]};
                    const f32x2v t2 = a2 * k_; f32x2v e2; e2.x = __builtin_amdgcn_exp2f(t2.x); e2.y = __builtin_amdgcn_exp2f(t2.y);
                    const f32x2v d2 = e2 + 1.0f; f32x2v i2; i2.x = __builtin_amdgcn_rcpf(d2.x); i2.y = __builtin_amdgcn_rcpf(d2.y);
                    const f32x2v h2 = ((a2 * b2) * r2_) * i2; wq[q] = cvt_pk_bf16(h2.x, h2.y); }
                u32x4 w; w.x = wq[0]; w.y = wq[1]; w.z = wq[2]; w.w = wq[3];
                *(PG8_GAS u32x4*)(H + (size_t)row * ldh + col0) = w; }
    }
};
struct EpiRes {
    static constexpr bool PERM = true, AFTER_DRAIN = false;
    float* xout; _Float16* xh; float* ssq; float alpha;
    __device__ __forceinline__ void operator()(const f32x4 (&acc)[2][2][4][2], const Unit& u, int wr, int wc, int fr, int fq) const {
        const int row0 = u.pm * BM + wr * 64 + fr, col0 = u.pn * BM + wc * 32 + 8 * fq;
#pragma unroll
        for (int ai = 0; ai < 2; ++ai) {
            u32x4 xv[4][2];
#pragma unroll
            for (int m = 0; m < 4; ++m)
#pragma unroll
                for (int bj = 0; bj < 2; ++bj) xv[m][bj] = *(const PG8_GAS u32x4*)(xh + (size_t)(row0 + ai * HALF + m * 16) * 1024 + col0 + bj * HALF);
#pragma unroll
            for (int m = 0; m < 4; ++m) { const int row = row0 + ai * HALF + m * 16; float ss = 0.f;
#pragma unroll
                for (int bj = 0; bj < 2; ++bj) { const size_t off = (size_t)row * 1024 + col0 + bj * HALF; const u32x4 r = xv[m][bj];
                    const h16x8 hv = __builtin_bit_cast(h16x8, r);
                    f32x4 x0 = {(float)hv[0], (float)hv[1], (float)hv[2], (float)hv[3]}, x1 = {(float)hv[4], (float)hv[5], (float)hv[6], (float)hv[7]};
                    x0 = x0 + acc[ai][bj][m][0] * alpha; x1 = x1 + acc[ai][bj][m][1] * alpha;
                    if (xout) { *(PG8_GAS f32x4*)(xout + off) = x0; *(PG8_GAS f32x4*)(xout + off + 4) = x1; }
                    const h16x8 ho = {(_Float16)x0[0], (_Float16)x0[1], (_Float16)x0[2], (_Float16)x0[3], (_Float16)x1[0], (_Float16)x1[1], (_Float16)x1[2], (_Float16)x1[3]};
                    *(PG8_GAS u32x4*)(xh + off) = __builtin_bit_cast(u32x4, ho);
                    ss += (x0[0] * x0[0] + x0[1] * x0[1]) + (x0[2] * x0[2] + x0[3] * x0[3]) + (x1[0] * x1[0] + x1[1] * x1[1]) + (x1[2] * x1[2] + x1[3] * x1[3]); }
                ss += __shfl_xor(ss, 16); ss += __shfl_xor(ss, 32);
                if (fq == 0) *(PG8_GAS float*)(ssq + (size_t)row * 16 + u.pn * 4 + wc) = ss; }
        }
    }
};
struct EpiProj {
    static constexpr bool PERM = true, AFTER_DRAIN = false;
    bf16_t* O; int ldc; const float* ssq; int qcols; float qscale;
    __device__ __forceinline__ void operator()(const f32x4 (&acc)[2][2][4][2], const Unit& u, int wr, int wc, int fr, int fq) const {
        const int row0 = u.pm * BM + wr * 64 + fr, col0 = u.pn * BM + wc * 32 + 8 * fq;
        float rs[2][4];
        { const int l64 = fr + 16 * fq; float rsl[2];
#pragma unroll
          for (int ai = 0; ai < 2; ++ai) rsl[ai] = rowscale(ssq, u.pm * BM + ai * HALF + wr * 64 + l64);
#pragma unroll
          for (int ai = 0; ai < 2; ++ai)
#pragma unroll
              for (int m = 0; m < 4; ++m) rs[ai][m] = __shfl(rsl[ai], m * 16 + fr); }
#pragma unroll
        for (int ai = 0; ai < 2; ++ai)
#pragma unroll
            for (int m = 0; m < 4; ++m) { const int row = row0 + ai * HALF + m * 16;
#pragma unroll
                for (int bj = 0; bj < 2; ++bj) { const int col = col0 + bj * HALF; const float sc = rs[ai][m] * (col < qcols ? qscale : 1.0f);
                    const f32x4 v0 = acc[ai][bj][m][0] * sc, v1 = acc[ai][bj][m][1] * sc;
                    u32x4 w; w.x = cvt_pk_bf16(v0[0], v0[1]); w.y = cvt_pk_bf16(v0[2], v0[3]); w.z = cvt_pk_bf16(v1[0], v1[1]); w.w = cvt_pk_bf16(v1[2], v1[3]);
                    *(PG8_GAS u32x4*)(O + (size_t)row * ldc + col) = w; } }
    }
};

template <bool F16> __device__ __forceinline__ f32x4 mma16(const bf16x8 a, const bf16x8 b, const f32x4 c) {
    if constexpr (F16) return __builtin_amdgcn_mfma_f32_16x16x32_f16(__builtin_bit_cast(h16x8, a), __builtin_bit_cast(h16x8, b), c, 0, 0, 0);
    else return __builtin_amdgcn_mfma_f32_16x16x32_bf16(a, b, c, 0, 0, 0);
}
template <class Epi, class Sched, bool ALIGN_EPI = false, bool SP2 = false, bool F16 = false>
__device__ __forceinline__ void gemm_phase(PG8_LAS unsigned char* lds, const Gemm g, const Sched& S, const Epi& E, const int tid) {
    const int wid = __builtin_amdgcn_readfirstlane(tid >> 6), lane = tid & 63, wr = wid >> 2, wc = wid & 3, fr = lane & 15, fq = lane >> 4;
    const int K = g.K, nt = K / BK;
    unsigned voffA[2], voffB[2];
#pragma unroll
    for (int i = 0; i < 2; ++i) { int R, C; stage_rc(tid * 16 + i * 8192, R, C); const int Rb = Epi::PERM ? ((R & ~31) + perm32(R & 31)) : R;
        voffA[i] = (unsigned)(R * K + C) * 2u; voffB[i] = (unsigned)(tid * 16 + i * 8192); (void)Rb; }
    const size_t kstep = (size_t)(BK * 2);
    const size_t hstep = (size_t)HALF * K * 2;
    const size_t tstep = 2 * hstep;
    const size_t kstepB = 32768, hstepB = 16384, tstepB = (size_t)nt * 32768;
    const unsigned ldsw = (unsigned)wid * 1024u;
    const int aoff = lds_byte(wr * 64 + fr, fq * 8), boff = lds_byte(wc * 32 + fr, fq * 8);
#define PG8_SA(b, h) (((b) * 2 + (h)) * HTB)
#define PG8_SB(b, h) ((4 + (b) * 2 + (h)) * HTB)
#define PG8_STAGE(bufoff, gbase, voff) do { _Pragma("unroll") for (int _i = 0; _i < 2; ++_i) \
        __builtin_amdgcn_global_load_lds((const unsigned*)((const char*)(gbase) + (voff)[_i]), (PG8_LAS unsigned*)(lds + (bufoff) + ldsw + _i * 8192), 16, 0, 0); } while (0)
#define PG8_LDA(dst, b, h) do { _Pragma("unroll") for (int m = 0; m < 4; ++m) _Pragma("unroll") for (int k = 0; k < 2; ++k) dst[m][k] = *(const PG8_LAS bf16x8*)(lds + PG8_SA(b, h) + aoff + m * 2048 + k * 1024); } while (0)
#define PG8_LDB(dst, b, h) do { _Pragma("unroll") for (int n = 0; n < 2; ++n) _Pragma("unroll") for (int k = 0; k < 2; ++k) dst[n][k] = *(const PG8_LAS bf16x8*)(lds + PG8_SB(b, h) + boff + n * 2048 + k * 1024); } while (0)
#define PG8_MMA(ai, bj, At, Bt) do { __builtin_amdgcn_s_setprio(1); _Pragma("unroll") for (int m = 0; m < 4; ++m) _Pragma("unroll") for (int n = 0; n < 2; ++n) _Pragma("unroll") for (int k = 0; k < 2; ++k) \
        acc[ai][bj][m][n] = mma16<F16>(Bt[n][k], At[m][k], acc[ai][bj][m][n]); __builtin_amdgcn_s_setprio(0); } while (0)
#define PG8_WAIT_V(n) asm volatile("s_waitcnt vmcnt(" #n ")" ::: "memory")
#define PG8_WAIT_L(n) asm volatile("s_waitcnt lgkmcnt(" #n ")" ::: "memory")
#define PG8_BAR __builtin_amdgcn_s_barrier()
#define PG8_SCHED __builtin_amdgcn_sched_barrier(0)
    Unit cur, nxt; int ui = 0;
    if (!S.next(0, cur)) return;
    f32x4 acc[2][2][4][2];
#pragma unroll
    for (int a = 0; a < 2; ++a)
#pragma unroll
        for (int b = 0; b < 2; ++b)
#pragma unroll
            for (int m = 0; m < 4; ++m)
#pragma unroll
                for (int n = 0; n < 2; ++n) acc[a][b][m][n] = (f32x4){0.f, 0.f, 0.f, 0.f};
    bf16x8 At[4][2], B0[2][2], B1[2][2];
    const char* cA = (const char*)g.A + (size_t)cur.pm * tstep; const char* cB = (const char*)g.Bt + (size_t)cur.pn * tstepB;
    S.a_ready(cur);
    if constexpr (SP2) {
        PG8_STAGE(PG8_SB(0, 0), cB, voffB); PG8_STAGE(PG8_SB(0, 1), cB + hstepB, voffB); PG8_STAGE(PG8_SA(0, 0), cA, voffA); PG8_STAGE(PG8_SA(0, 1), cA + hstep, voffA);
        if (wr == 1) PG8_BAR;
        PG8_WAIT_V(2); PG8_BAR;
        PG8_STAGE(PG8_SB(1, 0), cB + kstepB, voffB); PG8_STAGE(PG8_SA(1, 0), cA + kstep, voffA); PG8_STAGE(PG8_SB(1, 1), cB + hstepB + kstepB, voffB);
        PG8_WAIT_V(6); PG8_BAR;
    } else {
        PG8_STAGE(PG8_SB(0, 0), cB, voffB); PG8_STAGE(PG8_SA(0, 0), cA, voffA); PG8_STAGE(PG8_SB(0, 1), cB + hstepB, voffB); PG8_STAGE(PG8_SA(0, 1), cA + hstep, voffA);
        if (wr == 1) PG8_BAR;
        PG8_WAIT_V(4); PG8_BAR;
        PG8_STAGE(PG8_SB(1, 0), cB + kstepB, voffB); PG8_STAGE(PG8_SA(1, 0), cA + kstep, voffA); PG8_STAGE(PG8_SB(1, 1), cB + hstepB + kstepB, voffB);
        PG8_WAIT_V(6); PG8_BAR;
    }
    for (;;) {
        const bool has_next = S.next(ui + 1, nxt);
        const char* nA = has_next ? (const char*)g.A + (size_t)nxt.pm * tstep : cA; const char* nB = has_next ? (const char*)g.Bt + (size_t)nxt.pn * tstepB : cB;
        for (int t = 0; t < nt; t += 2) {
            const bool last = (t == nt - 2);
            const char* a1 = cA + (size_t)(t + 1) * kstep;
            const char* a2 = last ? nA : cA + (size_t)(t + 2) * kstep; const char* b2 = last ? nB : cB + (size_t)(t + 2) * kstepB;
            const char* a3 = a2 + kstep; const char* b3 = b2 + kstepB;
            if (last && has_next) S.a_ready(nxt);
            if constexpr (SP2) {
            PG8_LDB(B0, 0, 0); PG8_LDB(B1, 0, 1); PG8_SCHED; PG8_LDA(At, 0, 0); PG8_STAGE(PG8_SA(1, 1), a1 + hstep, voffA);
            PG8_WAIT_V(8); PG8_WAIT_L(0); PG8_BAR; PG8_MMA(0, 0, At, B0); PG8_MMA(0, 1, At, B1); PG8_BAR; PG8_SCHED;
            PG8_LDA(At, 0, 1); PG8_STAGE(PG8_SB(0, 0), b2, voffB); PG8_STAGE(PG8_SB(0, 1), b2 + hstepB, voffB); PG8_STAGE(PG8_SA(0, 0), a2, voffA);
            PG8_WAIT_V(8); PG8_WAIT_L(0); PG8_BAR; PG8_MMA(1, 0, At, B0); PG8_MMA(1, 1, At, B1); PG8_BAR; PG8_SCHED;
            PG8_LDB(B0, 1, 0); PG8_LDB(B1, 1, 1); PG8_SCHED; PG8_LDA(At, 1, 0); PG8_STAGE(PG8_SA(0, 1), a2 + hstep, voffA);
            PG8_WAIT_V(8); PG8_WAIT_L(0); PG8_BAR; PG8_MMA(0, 0, At, B0); PG8_MMA(0, 1, At, B1); PG8_BAR; PG8_SCHED;
            PG8_LDA(At, 1, 1); PG8_STAGE(PG8_SB(1, 0), b3, voffB); PG8_STAGE(PG8_SB(1, 1), b3 + hstepB, voffB); PG8_STAGE(PG8_SA(1, 0), a3, voffA);
            PG8_WAIT_V(8); PG8_WAIT_L(0); PG8_BAR; PG8_MMA(1, 0, At, B0); PG8_MMA(1, 1, At, B1); PG8_BAR; PG8_SCHED;
            } else {
            PG8_LDB(B0, 0, 0); PG8_SCHED; PG8_LDA(At, 0, 0); PG8_STAGE(PG8_SA(1, 1), a1 + hstep, voffA);
            PG8_WAIT_L(8); PG8_BAR; PG8_WAIT_L(0); PG8_MMA(0, 0, At, B0); PG8_BAR; PG8_SCHED;
            PG8_LDB(B1, 0, 1); PG8_STAGE(PG8_SB(0, 0), b2, voffB);
            PG8_BAR; PG8_WAIT_L(0); PG8_MMA(0, 1, At, B1); PG8_BAR;
            PG8_LDA(At, 0, 1); PG8_STAGE(PG8_SA(0, 0), a2, voffA);
            PG8_BAR; PG8_WAIT_L(0); PG8_MMA(1, 0, At, B0); PG8_BAR; PG8_SCHED;
            PG8_STAGE(PG8_SB(0, 1), b2 + hstepB, voffB);
            PG8_WAIT_V(6); PG8_BAR; PG8_MMA(1, 1, At, B1); PG8_BAR;
            PG8_LDB(B0, 1, 0); PG8_SCHED; PG8_LDA(At, 1, 0); PG8_STAGE(PG8_SA(0, 1), a2 + hstep, voffA);
            PG8_WAIT_L(8); PG8_BAR; PG8_WAIT_L(0); PG8_MMA(0, 0, At, B0); PG8_BAR; PG8_SCHED;
            PG8_LDB(B1, 1, 1); PG8_STAGE(PG8_SB(1, 0), b3, voffB);
            PG8_BAR; PG8_WAIT_L(0); PG8_MMA(0, 1, At, B1); PG8_BAR;
            PG8_LDA(At, 1, 1); PG8_STAGE(PG8_SA(1, 0), a3, voffA);
            PG8_BAR; PG8_WAIT_L(0); PG8_MMA(1, 0, At, B0); PG8_BAR; PG8_SCHED;
            PG8_STAGE(PG8_SB(1, 1), b3 + hstepB, voffB);
            PG8_WAIT_V(6); PG8_BAR; PG8_MMA(1, 1, At, B1); PG8_BAR;
            }
        }
        if constexpr (ALIGN_EPI) { if (wr == 0) PG8_BAR; }
        if constexpr (!Epi::AFTER_DRAIN) { E(acc, cur, wr, wc, fr, fq); S.done(cur); }
        if (!has_next) break;
#pragma unroll
        for (int a = 0; a < 2; ++a)
#pragma unroll
            for (int b = 0; b < 2; ++b)
#pragma unroll
                for (int m = 0; m < 4; ++m)
#pragma unroll
                    for (int n = 0; n < 2; ++n) acc[a][b][m][n] = (f32x4){0.f, 0.f, 0.f, 0.f};
        cur = nxt; cA = nA; cB = nB; ++ui;
        if constexpr (ALIGN_EPI) { if (wr == 1) PG8_BAR; }
    }
    PG8_WAIT_V(0);
    if constexpr (!ALIGN_EPI) { if (wr == 0) PG8_BAR; }
    PG8_BAR;
    if constexpr (Epi::AFTER_DRAIN) { E.fused(acc, cur, wr, wc, fr, fq, lds, wid, lane); S.done(cur); }
#undef PG8_SA
#undef PG8_SB
#undef PG8_STAGE
#undef PG8_LDA
#undef PG8_LDB
#undef PG8_MMA
#undef PG8_WAIT_V
#undef PG8_WAIT_L
#undef PG8_BAR
#undef PG8_SCHED
}
}
using pg8::bf16_t; using pg8::bf16x8; using pg8::f32x4; using pg8::u32x4;
#define LAS __attribute__((address_space(3)))
typedef float f32x16 __attribute__((ext_vector_type(16)));
typedef short s16x4 __attribute__((ext_vector_type(4)));
typedef float f32x2_t __attribute__((ext_vector_type(2)));
typedef __bf16 bf16x2_t __attribute__((ext_vector_type(2)));
#define LDS_WAIT() asm volatile("s_waitcnt lgkmcnt(0)" ::: "memory")
#define MFMA32(a, b, c) __builtin_amdgcn_mfma_f32_32x32x16_bf16((a), (b), (c), 0, 0, 0)

constexpr int NB = 4, SEQ = 8192, TOK = NB * SEQ, DM = 1024, DFF = 2816, DRNN = 512, HYW = 2816, HYIN = 2568, SBW = 3072, NCHUNK = SEQ / 128;
constexpr float LOG2E = 1.4426950408889634f, QSC = 0.125f * 1.4426950408889634f;
constexpr size_t SZ_WFI = (size_t)2 * DFF * DM * 2, SZ_WFO = (size_t)DM * DFF * 2, SZ_WHI = (size_t)HYW * DM * 2, SZ_W1K = (size_t)DM * DM * 2, SZ_WSQ = (size_t)SBW * DM * 2;
constexpr size_t WS_WFI = 0, WS_WFO = WS_WFI + 8 * SZ_WFI, WS_WHI = WS_WFO + 8 * SZ_WFO, WS_WHO = WS_WHI + 2 * SZ_WHI, WS_WSQ = WS_WHO + 2 * SZ_W1K, WS_WSO = WS_WSQ + 2 * SZ_WSQ;
constexpr size_t WS_XB = WS_WSO + 2 * SZ_W1K, WS_SSQ = WS_XB + (size_t)TOK * DM * 2, WS_BIG = WS_SSQ + (size_t)TOK * 16 * 4, WS_YB = WS_BIG + (size_t)TOK * SBW * 2;
constexpr size_t WS_HL = WS_YB + (size_t)TOK * DM * 2, WS_PL = WS_HL + (size_t)TOK * DRNN * 4, WS_CA = WS_PL + (size_t)TOK * DRNN * 4, WS_CB = WS_CA + (size_t)NB * NCHUNK * DRNN * 4;
constexpr size_t WS_CL = WS_CB + (size_t)NB * NCHUNK * DRNN * 4, WS_TOT = WS_CL + (size_t)NB * 8 * SEQ * 4, WS_CTL = WS_TOT + (size_t)NB * 8 * NCHUNK * 4, WS_XH = WS_CTL + 16384, WS_END = WS_XH + (size_t)TOK * DM * 2;
constexpr int LDS_BYTES = 131072 + 4096;

DI float bf2f(bf16_t v) { return __uint_as_float((unsigned)v << 16); }
DI unsigned cvtpk(float lo, float hi) { f32x2_t v = {lo, hi}; bf16x2_t b = __builtin_convertvector(v, bf16x2_t); return __builtin_bit_cast(unsigned, b); }
DI float wave_sum(float v) {
#pragma unroll
    for (int o = 1; o < 64; o <<= 1) v += __shfl_xor(v, o);
    return v;
}
DI float wave_incl_scan(float v, int lane) {
#pragma unroll
    for (int o = 1; o < 64; o <<= 1) { const float t = __shfl_up(v, o); if (lane >= o) v += t; }
    return v;
}
DI float sigmoid_f(float x) { return __builtin_amdgcn_rcpf(1.0f + __builtin_amdgcn_exp2f(-1.4426950408889634f * x)); }
DI float gelu_tanh_f(float x) { const float u = 0.7978845608028654f * (x + 0.044715f * x * x * x); const float t = 1.0f - 2.0f * __builtin_amdgcn_rcpf(__builtin_amdgcn_exp2f(2.8853900817779268f * u) + 1.0f); return 0.5f * x * (1.0f + t); }
DI float neg_expm1_f(float t) {
    const float ser = -t * (1.0f + t * (0.5f + t * (0.16666667f + t * (0.041666668f + t * 0.0083333338f))));
    const float dir = 1.0f - __builtin_amdgcn_exp2f(1.4426950408889634f * t);
    return (t > -0.25f) ? ser : dir;
}

struct Args { const float* in[16]; float* out; unsigned char* ws; int ph_lo, ph_hi; };
struct Frame { LAS unsigned char* lds; int tid, lane, wave, vcu, G, bx, z; };

DI unsigned cvtpk_h(float lo, float hi) { typedef _Float16 h16x2 __attribute__((ext_vector_type(2))); const unsigned b = cvtpk(lo, hi);
    const h16x2 v = {(_Float16)__uint_as_float(b << 16), (_Float16)__uint_as_float(b & 0xffff0000u)}; return __builtin_bit_cast(unsigned, v); }
template <bool F16> DI void p0_item(const float* W, int K, int N, bf16_t* WT, int mode, const float* g, LAS float* scr, int item, int lane, int NP = 0) {
    if (NP == 0) NP = N;
    const int nblk = (NP + 31) >> 5, kb = item / nblk, nb = item - kb * nblk, k0 = 64 * kb, n0 = 32 * nb;
    const int n = n0 + (lane & 31);
    float wv[32];
    const float* wp = W + (size_t)(k0 + (lane >> 5)) * N + (n < N ? n : 0);
#pragma unroll
    for (int i = 0; i < 32; ++i) wv[i] = wp[(size_t)(2 * i) * N];
    if (g) {
#pragma unroll
        for (int i = 0; i < 32; ++i) wv[i] *= g[k0 + 2 * i + (lane >> 5)];
    }
#pragma unroll
    for (int i = 0; i < 32; ++i) scr[(2 * i + (lane >> 5)) * 33 + (lane & 31)] = (n < N) ? wv[i] : 0.f;
    LDS_WAIT();
    const int c = lane & 7;
#pragma unroll
    for (int j = 0; j < 4; ++j) { const int nn = (lane >> 3) + 8 * j; const LAS float* s = scr + (8 * c) * 33 + nn;
        u32x4 o;
        if constexpr (F16) { o.x = cvtpk_h(s[0 * 33], s[1 * 33]); o.y = cvtpk_h(s[2 * 33], s[3 * 33]); o.z = cvtpk_h(s[4 * 33], s[5 * 33]); o.w = cvtpk_h(s[6 * 33], s[7 * 33]); }
        else { o.x = cvtpk(s[0 * 33], s[1 * 33]); o.y = cvtpk(s[2 * 33], s[3 * 33]); o.z = cvtpk(s[4 * 33], s[5 * 33]); o.w = cvtpk(s[6 * 33], s[7 * 33]); }
        const int sn = n0 + nn; int dr = sn;
        if (mode == 1) { const int isb = sn >= DFF ? 1 : 0; const int jj = sn - isb * DFF; dr = 256 * (jj >> 7) + 128 * isb + (jj & 127); }
        const int x = dr & 127, y = x & 31, R = (x & ~31) + 16 * ((y >> 2) & 1) + 4 * (y >> 3) + (y & 3);
        const size_t blk = ((size_t)(dr >> 8) * (K >> 6) + (k0 >> 6)) * 2 + ((dr >> 7) & 1);
        *(u32x4*)((unsigned char*)WT + blk * 16384 + pg8::lds_byte(R, 8 * c)) = o; }
    LDS_WAIT();
}
DI void p0_prologue(const Frame& F, const Args& A, unsigned char* ws) {
#define in(i) (A.in[(i) + F.z])
    LAS float* scr = (LAS float*)(F.lds + F.wave * 16384);
    const int gw = F.vcu * 8 + F.wave, NGW = F.G * 8, lane = F.lane;
    const float* ffn_norm = in(1); const float* ffn_w_in = in(2); const float* ffn_w_out = in(3); const float* mix_norm = in(4); const float* hy_w_in = in(5);
    const float* hy_w_out = in(13); const float* sb_w_qkv = in(14); const float* sb_w_out = in(15);
    { constexpr int I = (DM / 64) * (2 * DFF / 32);
      for (int it = gw; it < 8 * I; it += NGW) { const int mi = it / I, r = it - mi * I; p0_item<true>(ffn_w_in + (size_t)mi * DM * 2 * DFF, DM, 2 * DFF, (bf16_t*)(ws + WS_WFI + mi * SZ_WFI), 1, ffn_norm + mi * DM, scr, r, lane); } }
    { constexpr int I = (DFF / 64) * (DM / 32);
      for (int it = gw; it < 8 * I; it += NGW) { const int mi = it / I, r = it - mi * I; p0_item<false>(ffn_w_out + (size_t)mi * DFF * DM, DFF, DM, (bf16_t*)(ws + WS_WFO + mi * SZ_WFO), 0, nullptr, scr, r, lane); } }
    { constexpr int I = (DM / 64) * (HYW / 32);
      for (int it = gw; it < 2 * I; it += NGW) { const int mi = it / I, r = it - mi * I; p0_item<true>(hy_w_in + (size_t)mi * DM * HYIN, DM, HYIN, (bf16_t*)(ws + WS_WHI + mi * SZ_WHI), 0, mix_norm + (2 * mi) * DM, scr, r, lane, HYW); } }
    { constexpr int I = (DM / 64) * (DM / 32);
      for (int it = gw; it < 2 * I; it += NGW) { const int mi = it / I, r = it - mi * I; p0_item<false>(hy_w_out + (size_t)mi * DM * DM, DM, DM, (bf16_t*)(ws + WS_WHO + mi * SZ_W1K), 0, nullptr, scr, r, lane); } }
    { constexpr int I = (DM / 64) * (SBW / 32);
      for (int it = gw; it < 2 * I; it += NGW) { const int mi = it / I, r = it - mi * I; p0_item<true>(sb_w_qkv + (size_t)mi * DM * SBW, DM, SBW, (bf16_t*)(ws + WS_WSQ + mi * SZ_WSQ), 0, mix_norm + (2 * mi + 1) * DM, scr, r, lane); } }
    { constexpr int I = (DM / 64) * (DM / 32);
      for (int it = gw; it < 2 * I; it += NGW) { const int mi = it / I, r = it - mi * I; p0_item<false>(sb_w_out + (size_t)mi * DM * DM, DM, DM, (bf16_t*)(ws + WS_WSO + mi * SZ_W1K), 0, nullptr, scr, r, lane); } }
    const float* x = in(0); float* SSQ = (float*)(ws + WS_SSQ);
    for (int m = gw; m < TOK; m += NGW) {
        const f32x4* xr = (const f32x4*)(x + (size_t)m * DM) + lane; f32x4 v[4]; float s = 0.f;
#pragma unroll
        for (int j = 0; j < 4; ++j) { v[j] = xr[64 * j]; s += (v[j][0] * v[j][0] + v[j][1] * v[j][1]) + (v[j][2] * v[j][2] + v[j][3] * v[j][3]); }
        s = wave_sum(s);
        typedef _Float16 h16x4 __attribute__((ext_vector_type(4)));
        unsigned long long* h8 = (unsigned long long*)((_Float16*)(ws + WS_XH) + (size_t)m * DM) + lane;
#pragma unroll
        for (int j = 0; j < 4; ++j) { const h16x4 hv = {(_Float16)v[j][0], (_Float16)v[j][1], (_Float16)v[j][2], (_Float16)v[j][3]}; h8[64 * j] = __builtin_bit_cast(unsigned long long, hv); }
        if (lane < 16) SSQ[(size_t)m * 16 + lane] = (lane == 0) ? s : 0.f;
    }
}

DI void rglru_passA(const Frame& F, const Args& A, int e, unsigned char* ws) {
    const bf16_t* PROJ = (const bf16_t*)(ws + WS_BIG);
    float* HL = (float*)(ws + WS_HL); float* PL = (float*)(ws + WS_PL); float* CA = (float*)(ws + WS_CA); float* CB = (float*)(ws + WS_CB);
    const int hb = F.vcu & 7, j = F.lane, w = F.wave, ch = hb * 64 + j, r32 = j & 31, hi = j >> 5;
    const float* cw = in(6) + (size_t)e * 4 * DRNN; const float* cbp = in(7) + (size_t)e * DRNN; const float* gw = in(8) + (size_t)e * 2 * 8 * 64 * 64;
    const float* gb = in(9) + (size_t)e * 2 * DRNN; const float* lam = in(10) + (size_t)e * DRNN;
    const int mt = w & 3, gate = w >> 2;
    bf16x8 bw[2][4];
#pragma unroll
    for (int th = 0; th < 2; ++th)
#pragma unroll
        for (int sft = 0; sft < 4; ++sft) { const float* p = gw + ((size_t)(gate * 8 + hb) * 64 + 16 * sft + 8 * hi) * 64 + 32 * th + r32;
            u32x4 q; q.x = cvtpk(p[0], p[64]); q.y = cvtpk(p[128], p[192]); q.z = cvtpk(p[256], p[320]); q.w = cvtpk(p[384], p[448]); bw[th][sft] = __builtin_bit_cast(bf16x8, q); }
    const float cw0 = cw[0 * DRNN + ch], cw1 = cw[1 * DRNN + ch], cw2 = cw[2 * DRNN + ch], cw3 = cw[3 * DRNN + ch], cb0 = cbp[ch];
    const float br = gb[ch], bi = gb[DRNN + ch];
    const float sp8 = -8.0f * log1pf(expf(-lam[ch]));
    constexpr int XCB_PITCH = 144, G_PITCH = 132;
    LAS float* xcs = (LAS float*)(F.lds); LAS unsigned char* xcb = F.lds + 32768; LAS float* G = (LAS float*)(F.lds + 51200);
    LAS float* gA = (LAS float*)(F.lds + 118784); LAS float* gB = (LAS float*)(F.lds + 118784 + 2048);
    for (int idx = F.vcu >> 3; idx < NB * NCHUNK; idx += (F.G >> 3)) {
        const int b = idx / NCHUNK, c = idx - b * NCHUNK; const int s0 = c * 128 + 16 * w; const size_t row0 = (size_t)b * SEQ + s0;
        float u0, u1, u2;
        u0 = (s0 >= 3) ? bf2f(PROJ[(row0 - 3) * HYW + ch]) : 0.f; u1 = (s0 >= 2) ? bf2f(PROJ[(row0 - 2) * HYW + ch]) : 0.f; u2 = (s0 >= 1) ? bf2f(PROJ[(row0 - 1) * HYW + ch]) : 0.f;
        float uv[16];
#pragma unroll
        for (int t = 0; t < 16; ++t) uv[t] = bf2f(PROJ[(row0 + t) * HYW + ch]);
#pragma unroll
        for (int t = 0; t < 16; ++t) { const float u3 = uv[t]; const float xc = cb0 + cw0 * u0 + cw1 * u1 + cw2 * u2 + cw3 * u3;
            xcs[(16 * w + t) * 64 + j] = xc; *(LAS bf16_t*)(xcb + (16 * w + t) * XCB_PITCH + 2 * j) = (bf16_t)(cvtpk(xc, xc) & 0xffffu); u0 = u1; u1 = u2; u2 = u3; }
        LDS_WAIT(); __syncthreads();
        {
            f32x16 acc0, acc1;
#pragma unroll
            for (int r = 0; r < 16; ++r) { acc0[r] = 0.f; acc1[r] = 0.f; }
            bf16x8 af[4];
#pragma unroll
            for (int sft = 0; sft < 4; ++sft) af[sft] = *(const LAS bf16x8*)(xcb + (32 * mt + r32) * XCB_PITCH + (16 * sft + 8 * hi) * 2);
#pragma unroll
            for (int sft = 0; sft < 4; ++sft) { acc0 = MFMA32(af[sft], bw[0][sft], acc0); acc1 = MFMA32(af[sft], bw[1][sft], acc1); }
#pragma unroll
            for (int r = 0; r < 16; ++r) { const int tok = 32 * mt + (r & 3) + 8 * (r >> 2) + 4 * hi;
                G[tok * G_PITCH + gate * 64 + r32] = acc0[r]; G[tok * G_PITCH + gate * 64 + 32 + r32] = acc1[r]; }
        }
        LDS_WAIT(); __syncthreads();
        float h = 0.f, P = 1.f;
#pragma unroll 4
        for (int t = 0; t < 16; ++t) {
            LAS float* gp = G + (16 * w + t) * G_PITCH + j;
            const float r = sigmoid_f(gp[0] + br), ig = sigmoid_f(gp[64] + bi);
            const float la = sp8 * r, a = __builtin_amdgcn_exp2f(1.4426950408889634f * la), bb = __builtin_amdgcn_sqrtf(neg_expm1_f(2.0f * la)) * ig * xcs[(16 * w + t) * 64 + j];
            h = a * h + bb; P = a * P;
            gp[0] = h; gp[64] = P;
        }
        gA[w * 64 + j] = P; gB[w * 64 + j] = h;
        LDS_WAIT(); __syncthreads();
        float Hin = 0.f, Pin = 1.f;
        for (int w2 = 0; w2 < w; ++w2) { const float a = gA[w2 * 64 + j], bq = gB[w2 * 64 + j]; Hin = a * Hin + bq; Pin *= a; }
        float hv = 0.f, pv = 1.f;
#pragma unroll 4
        for (int t = 0; t < 16; ++t) { const float hl = G[(16 * w + t) * G_PITCH + j], pl = G[(16 * w + t) * G_PITCH + 64 + j]; hv = hl + pl * Hin; pv = pl * Pin;
            HL[(row0 + t) * DRNN + ch] = hv; PL[(row0 + t) * DRNN + ch] = pv; }
        if (w == 7) { CA[((size_t)b * NCHUNK + c) * DRNN + ch] = pv; CB[((size_t)b * NCHUNK + c) * DRNN + ch] = hv; }
        LDS_WAIT(); __syncthreads();
    }
}
DI void hy_prep(const Frame& F, const Args& A, int e, unsigned char* ws) {
    bf16_t* PROJ = (bf16_t*)(ws + WS_BIG); float* CL = (float*)(ws + WS_CL); float* TOT = (float*)(ws + WS_TOT);
    const float* fb = in(11) + (size_t)e * 8; const float* qkg = in(12) + (size_t)e * 2 * 64;
    const int tid = F.tid, sub = tid & 7;
    for (int idx = F.vcu; idx < NB * NCHUNK; idx += F.G) {
        const int b = idx / NCHUNK, c = idx - b * NCHUNK; const size_t row0 = (size_t)b * SEQ + c * 128;
        for (int it0 = 0; it0 < 32; it0 += 8) { u32x4 rawv[8];
#pragma unroll
          for (int ii = 0; ii < 8; ++ii) { const int rid = (it0 + ii) * 64 + (tid >> 3); rawv[ii] = *(const u32x4*)(PROJ + (row0 + (rid >> 4)) * HYW + 1024 + (rid & 15) * 64 + sub * 8); }
#pragma unroll
          for (int ii = 0; ii < 8; ++ii) { const int it = it0 + ii;
            const int rid = it * 64 + (tid >> 3), tok = rid >> 4, hq = rid & 15;
            bf16_t* p = PROJ + (row0 + tok) * HYW + 1024 + hq * 64 + sub * 8;
            const u32x4 raw = rawv[ii]; float v[8];
#pragma unroll
            for (int i = 0; i < 4; ++i) { v[2 * i] = __uint_as_float(raw[i] << 16); v[2 * i + 1] = __uint_as_float(raw[i] & 0xffff0000u); }
            float ss = 0.f;
#pragma unroll
            for (int i = 0; i < 8; ++i) ss += v[i] * v[i];
            ss += __shfl_xor(ss, 1); ss += __shfl_xor(ss, 2); ss += __shfl_xor(ss, 4);
            const float inv = __builtin_amdgcn_rsqf(ss * (1.0f / 64.0f) + 1e-6f) * (hq < 8 ? QSC : 1.0f);
            const float* g = qkg + (hq >> 3) * 64 + sub * 8;
            u32x4 o; o.x = cvtpk(v[0] * inv * g[0], v[1] * inv * g[1]); o.y = cvtpk(v[2] * inv * g[2], v[3] * inv * g[3]);
            o.z = cvtpk(v[4] * inv * g[4], v[5] * inv * g[5]); o.w = cvtpk(v[6] * inv * g[6], v[7] * inv * g[7]);
            *(u32x4*)p = o;
          } }
        { const int h = F.wave, l = F.lane; const float fbh = fb[h];
          const float x0 = bf2f(PROJ[(row0 + 2 * l) * HYW + 2560 + h]) + fbh, x1 = bf2f(PROJ[(row0 + 2 * l + 1) * HYW + 2560 + h]) + fbh;
          const float l0 = fminf(x0, 0.f) - log1pf(expf(-fabsf(x0))), l1 = fminf(x1, 0.f) - log1pf(expf(-fabsf(x1)));
          const float incl = wave_incl_scan(l0 + l1, l);
          float* cl = CL + ((size_t)b * 8 + h) * SEQ + c * 128 + 2 * l; cl[0] = incl - l1; cl[1] = incl;
          if (l == 63) TOT[((size_t)b * 8 + h) * NCHUNK + c] = incl; }
    }
}
DI void rglru_passC(const Frame& F, unsigned char* ws) {
    const bf16_t* PROJ = (const bf16_t*)(ws + WS_BIG); bf16_t* YB = (bf16_t*)(ws + WS_YB);
    const float* HL = (const float*)(ws + WS_HL); const float* PL = (const float*)(ws + WS_PL); const float* CA = (const float*)(ws + WS_CA); const float* CB = (const float*)(ws + WS_CB);
    const int c4 = (F.tid & 127) * 4, tq = F.tid >> 7;
    for (int idx = F.vcu; idx < NB * NCHUNK; idx += F.G) {
        const int b = idx / NCHUNK, c = idx - b * NCHUNK; const size_t row0 = (size_t)b * SEQ + c * 128 + tq * 32;
        f32x4 Hin = {0.f, 0.f, 0.f, 0.f};
        const f32x4* ca = (const f32x4*)(CA + (size_t)b * NCHUNK * DRNN + c4); const f32x4* cb = (const f32x4*)(CB + (size_t)b * NCHUNK * DRNN + c4);
        int c2 = 0;
        for (; c2 + 8 <= c; c2 += 8) { f32x4 av[8], bv[8];
#pragma unroll
            for (int i = 0; i < 8; ++i) { av[i] = ca[(size_t)(c2 + i) * (DRNN / 4)]; bv[i] = cb[(size_t)(c2 + i) * (DRNN / 4)]; }
#pragma unroll
            for (int i = 0; i < 8; ++i) Hin = av[i] * Hin + bv[i]; }
        for (; c2 < c; ++c2) Hin = ca[(size_t)c2 * (DRNN / 4)] * Hin + cb[(size_t)c2 * (DRNN / 4)];
        for (int t0 = 0; t0 < 32; t0 += 8) { f32x4 hv[8], pv[8]; unsigned long long gv[8];
#pragma unroll
            for (int i = 0; i < 8; ++i) { const size_t row = row0 + t0 + i; hv[i] = *(const f32x4*)(HL + row * DRNN + c4); pv[i] = *(const f32x4*)(PL + row * DRNN + c4); gv[i] = *(const unsigned long long*)(PROJ + row * HYW + 512 + c4); }
#pragma unroll
            for (int i = 0; i < 8; ++i) { const size_t row = row0 + t0 + i; const f32x4 hh = hv[i] + pv[i] * Hin;
                const float g0 = __uint_as_float((unsigned)(gv[i] & 0xffffull) << 16), g1 = __uint_as_float((unsigned)(gv[i] & 0xffff0000ull)), g2 = __uint_as_float((unsigned)((gv[i] >> 32) & 0xffffull) << 16), g3 = __uint_as_float((unsigned)((gv[i] >> 32) & 0xffff0000ull));
                const unsigned long long o = (unsigned long long)cvtpk(hh[0] * gelu_tanh_f(g0), hh[1] * gelu_tanh_f(g1)) | ((unsigned long long)cvtpk(hh[2] * gelu_tanh_f(g2), hh[3] * gelu_tanh_f(g3)) << 32);
                *(unsigned long long*)(YB + row * DM + c4) = o; } }
    }
}
constexpr int A_K = 0, A_V = 16384, A_WSF = 32768, A_PRE = A_WSF + 2048, A_FLG = A_PRE + 256, A_CBUF = 36864, A_OST = 69632;
DI int crow(int r, int hi) { return (r & 3) + 8 * (r >> 2) + 4 * hi; }
DI int pislot(int rho) { const int rp = rho & 31; return (rho & 32) + 16 * ((rp >> 2) & 1) + 4 * (rp >> 3) + (rp & 3); }
DI s16x4 vtr(const LAS unsigned char* p) { typedef short v4i16_t __attribute__((ext_vector_type(4))); return __builtin_bit_cast(s16x4, __builtin_amdgcn_ds_read_tr16_b64_v4i16((LAS v4i16_t*)p)); }
DI bf16x8 pack8(const f32x16& c, int s) { u32x4 p; p.x = cvtpk(c[8 * s], c[8 * s + 1]); p.y = cvtpk(c[8 * s + 2], c[8 * s + 3]); p.z = cvtpk(c[8 * s + 4], c[8 * s + 5]); p.w = cvtpk(c[8 * s + 6], c[8 * s + 7]); return __builtin_bit_cast(bf16x8, p); }
DI void sb_sub(f32x16& c, float& carry, int keybase, int qidx, bool band, int hi) {
    f32x16 nb;
#pragma unroll
    for (int r = 0; r < 16; ++r) { const float e = __builtin_amdgcn_exp2f(c[r]); nb[r] = __builtin_amdgcn_rcpf(1.0f + e); c[r] = 1.0f - nb[r]; }
    if (band) {
#pragma unroll
        for (int r = 0; r < 16; ++r) if (keybase + r >= qidx) { nb[r] = 1.0f; c[r] = 0.f; }
    }
    float s = 1.0f;
#pragma unroll
    for (int r = 15; r >= 0; --r) { const float beta = c[r]; c[r] = beta * s; s = s * nb[r]; }
    const float other = __shfl_xor(s, 32);
    const float factor = carry * (hi ? 1.0f : other);
#pragma unroll
    for (int r = 0; r < 16; ++r) c[r] *= factor;
    carry = carry * (s * other);
}
template <int MODE>
DI void attn_unit(int b, int h, int qb, const bf16_t* Qp, const bf16_t* Kp, const bf16_t* Vp, int pitch, bf16_t* Op, const float* CL, const float* TOT, int nh, LAS unsigned char* lds, const int tid) {
    const int lane = tid & 63, r32 = lane & 31, hi = lane >> 5; const int wid = __builtin_amdgcn_readfirstlane(tid >> 6);
    const size_t rowbase = (size_t)b * SEQ; const int q0 = qb * 256;
    const bf16_t* Qw = Qp + (rowbase + q0 + wid * 32) * pitch + h * 64;
    const bf16_t* Kh = Kp + rowbase * pitch + h * 64; const bf16_t* Vh = Vp + rowbase * pitch + h * 64;
    LAS float* wsf = (LAS float*)(lds + A_WSF) + wid * 64; LAS float* cbuf = (LAS float*)(lds + A_CBUF); LAS float* pre = (LAS float*)(lds + A_PRE);
    const int kslot = lane, vslot = 16 * (wid & 3) + (lane >> 2);
    const int kkey = MODE ? pislot(kslot) : kslot, vkey = MODE ? pislot(vslot) : vslot;
    const bf16_t* ksrc = Kh + (size_t)kkey * pitch + wid * 8; const bf16_t* vsrc = Vh + (size_t)vkey * pitch + (wid >> 2) * 32 + (lane & 3) * 8;
    const unsigned stoff = wid * 1024 + lane * 16;
    const int NT = (q0 + 256) / 64; const int qidx = q0 + wid * 32 + r32;
    f32x16 cinit;
#pragma unroll
    for (int r = 0; r < 16; ++r) cinit[r] = 0.f;
    if (MODE == 0) {
        if (wid == 0) { const float tv = TOT[((size_t)b * nh + h) * NCHUNK + lane]; const float inc = wave_incl_scan(tv, lane); pre[lane] = inc - tv; }
        LDS_WAIT(); __syncthreads();
        const float* cl = CL + ((size_t)b * nh + h) * SEQ;
        for (int jx = tid; jx < q0 + 256; jx += 512) cbuf[jx] = (cl[jx] + pre[jx >> 7]) * LOG2E;
        LDS_WAIT(); __syncthreads();
        const float cq = cbuf[qidx];
#pragma unroll
        for (int r = 0; r < 16; ++r) cinit[r] = cq;
    }
    bf16x8 qr[4];
#pragma unroll
    for (int d0 = 0; d0 < 4; ++d0) qr[d0] = *(const bf16x8*)(Qw + (size_t)r32 * pitch + d0 * 16 + hi * 8);
    f32x16 o[2];
#pragma unroll
    for (int r = 0; r < 16; ++r) { o[0][r] = 0.f; o[1][r] = 0.f; }
    float mrun = -INFINITY, lrun = 0.f, carry = 1.0f;
    u32x4 kreg, vreg;
    { const int t = MODE ? NT - 1 : 0; kreg = *(const u32x4*)(ksrc + (size_t)t * 64 * pitch); vreg = *(const u32x4*)(vsrc + (size_t)t * 64 * pitch); }
    *(LAS u32x4*)(lds + A_K + stoff) = kreg; *(LAS u32x4*)(lds + A_V + stoff) = vreg;
    LDS_WAIT(); __syncthreads();
    LAS unsigned* flg = (LAS unsigned*)(lds + A_FLG); bool walive = true;
    for (int it = 0; it < NT; ++it) {
        const int t = MODE ? NT - 1 - it : it; const unsigned boff = (it & 1) * 8192u;
        if (MODE == 1 && it > 0) {
            const u32x4 fa = *(const LAS u32x4*)(flg + ((it - 1) & 1) * 8), fb = *(const LAS u32x4*)(flg + ((it - 1) & 1) * 8 + 4);
            if (((fa.x | fa.y) | (fa.z | fa.w) | (fb.x | fb.y) | (fb.z | fb.w)) == 0u) break;
        }
        if (it + 1 < NT) { const int tn = MODE ? t - 1 : t + 1; kreg = *(const u32x4*)(ksrc + (size_t)tn * 64 * pitch); vreg = *(const u32x4*)(vsrc + (size_t)tn * 64 * pitch); }
        const bool live = (t * 64 < q0 + wid * 32 + 32) && (MODE == 0 || walive);
        if (live) {
        f32x16 c0 = cinit, c1 = cinit;
        { const LAS unsigned char* kb = lds + A_K + boff + hi * 1024 + r32 * 16;
          bf16x8 kf[8];
#pragma unroll
          for (int d0 = 0; d0 < 4; ++d0) { kf[2 * d0] = *(const LAS bf16x8*)(kb + d0 * 2048); kf[2 * d0 + 1] = *(const LAS bf16x8*)(kb + d0 * 2048 + 512); }
          __builtin_amdgcn_sched_barrier(0);
#pragma unroll
          for (int d0 = 0; d0 < 4; ++d0) { c0 = MFMA32(kf[2 * d0], qr[d0], c0); c1 = MFMA32(kf[2 * d0 + 1], qr[d0], c1); }
          __builtin_amdgcn_sched_barrier(0); }
        const bool band = (t * 64 + 63 >= q0 + wid * 32);
        if (MODE == 0) {
            const LAS f32x4* cb4 = (const LAS f32x4*)(cbuf + t * 64 + 4 * hi);
#pragma unroll
            for (int g = 0; g < 4; ++g) { const f32x4 b0 = cb4[2 * g], b1 = cb4[2 * g + 8];
#pragma unroll
                for (int i = 0; i < 4; ++i) { c0[4 * g + i] -= b0[i]; c1[4 * g + i] -= b1[i]; } }
            if (band) {
#pragma unroll
                for (int r = 0; r < 16; ++r) { const int key = t * 64 + crow(r, hi); if (key > qidx) c0[r] = -INFINITY; if (key + 32 > qidx) c1[r] = -INFINITY; }
            }
            float rm = fmaxf(c0[0], c1[0]);
#pragma unroll
            for (int r = 1; r < 16; ++r) rm = fmaxf(rm, fmaxf(c0[r], c1[r]));
            rm = fmaxf(rm, __shfl_xor(rm, 32));
            const float mnew = fmaxf(mrun, rm), f = __builtin_amdgcn_exp2f(mrun - mnew); mrun = mnew;
            float ps = 0.f;
#pragma unroll
            for (int r = 0; r < 16; ++r) { c0[r] = __builtin_amdgcn_exp2f(c0[r] - mnew); c1[r] = __builtin_amdgcn_exp2f(c1[r] - mnew); ps += c0[r] + c1[r]; }
            lrun = lrun * f + ps;
            if (hi == 0) wsf[r32] = f;
            LDS_WAIT();
#pragma unroll
            for (int g = 0; g < 4; ++g) { const f32x4 fv = *(const LAS f32x4*)(wsf + 8 * g + 4 * hi);
#pragma unroll
                for (int i = 0; i < 4; ++i) { o[0][4 * g + i] *= fv[i]; o[1][4 * g + i] *= fv[i]; } }
        } else {
            sb_sub(c1, carry, t * 64 + 32 + 16 * hi, qidx, band, hi);
            sb_sub(c0, carry, t * 64 + 16 * hi, qidx, band, hi);
        }
        const bf16x8 pa0 = pack8(c0, 0), pa1 = pack8(c0, 1), pa2 = pack8(c1, 0), pa3 = pack8(c1, 1);
        { const LAS unsigned char* vb = lds + A_V + boff + ((lane >> 4) & 1) * 32 + (lane & 3) * 8 + (4 * hi + ((lane & 15) >> 2)) * 64;
          bf16x8 vf[8];
#pragma unroll
          for (int i_ = 0; i_ < 8; ++i_) vf[i_] = __builtin_shufflevector(vtr(vb + (i_ >> 2) * 4096 + (i_ & 3) * 1024), vtr(vb + (i_ >> 2) * 4096 + (i_ & 3) * 1024 + 512), 0, 1, 2, 3, 4, 5, 6, 7);
          __builtin_amdgcn_sched_barrier(0);
#pragma unroll
          for (int d0 = 0; d0 < 2; ++d0) { o[d0] = MFMA32(pa0, vf[4 * d0], o[d0]); o[d0] = MFMA32(pa1, vf[4 * d0 + 1], o[d0]); o[d0] = MFMA32(pa2, vf[4 * d0 + 2], o[d0]); o[d0] = MFMA32(pa3, vf[4 * d0 + 3], o[d0]); }
          __builtin_amdgcn_sched_barrier(0); }
        }
        if (MODE == 1) { walive = __builtin_amdgcn_ballot_w64(carry > 8.673617379884035e-19f) != 0ull; if (lane == 0) flg[(it & 1) * 8 + wid] = walive ? 1u : 0u; }
        if (it + 1 < NT) { *(LAS u32x4*)(lds + A_K + (boff ^ 8192u) + stoff) = kreg; *(LAS u32x4*)(lds + A_V + (boff ^ 8192u) + stoff) = vreg; }
        LDS_WAIT(); __syncthreads();
    }
    f32x16 linv;
#pragma unroll
    for (int r = 0; r < 16; ++r) linv[r] = 1.0f;
    if (MODE == 0) {
        lrun += __shfl_xor(lrun, 32);
        if (hi == 0) wsf[r32] = lrun;
        LDS_WAIT();
#pragma unroll
        for (int g = 0; g < 4; ++g) { const f32x4 lv = *(const LAS f32x4*)(wsf + 8 * g + 4 * hi);
#pragma unroll
            for (int i = 0; i < 4; ++i) linv[4 * g + i] = 1.0f / lv[i]; }
    }
    { bf16_t* Ow = Op + (rowbase + q0 + wid * 32) * DM + h * 64;
      LAS bf16_t* stg = (LAS bf16_t*)(lds + A_OST) + wid * 2048;
#pragma unroll
      for (int r = 0; r < 16; ++r) { const int orow = crow(r, hi);
#pragma unroll
          for (int d0 = 0; d0 < 2; ++d0) { const float v = o[d0][r] * linv[r]; stg[orow * 64 + d0 * 32 + r32] = (bf16_t)(cvtpk(v, v) & 0xffffu); } }
      LDS_WAIT();
#pragma unroll
      for (int i = 0; i < 4; ++i) { const u32x4 v = *(const LAS u32x4*)(stg + lane * 8 + i * 512); *(u32x4*)(Ow + (size_t)(lane >> 3) * DM + (lane & 7) * 8 + (size_t)i * 8 * DM) = v; } }
    LDS_WAIT(); __syncthreads();
}

DI void fox_unit(int b, int h, int qb, const bf16_t* Qp, const bf16_t* Kp, const bf16_t* Vp, int pitch, bf16_t* Op, const float* CL, const float* TOT, float G2, LAS unsigned char* lds, const int tid) {
    const int lane = tid & 63, r32 = lane & 31, hi = lane >> 5; const int wid = __builtin_amdgcn_readfirstlane(tid >> 6);
    const size_t rowbase = (size_t)b * SEQ; const int q0 = qb * 256;
    const bf16_t* Qw = Qp + (rowbase + q0 + wid * 32) * pitch + h * 64;
    const bf16_t* Kh = Kp + rowbase * pitch + h * 64; const bf16_t* Vh = Vp + rowbase * pitch + h * 64;
    LAS float* wsf = (LAS float*)(lds + A_WSF) + wid * 64; LAS float* cbuf = (LAS float*)(lds + A_CBUF); LAS float* pre = (LAS float*)(lds + A_PRE);
    const bf16_t* ksrc = Kh + (size_t)lane * pitch + wid * 8; const bf16_t* vsrc = Vh + (size_t)(16 * (wid & 3) + (lane >> 2)) * pitch + (wid >> 2) * 32 + (lane & 3) * 8;
    const unsigned stoff = wid * 1024 + lane * 16;
    const int NT = (q0 + 256) / 64; const int qidx = q0 + wid * 32 + r32;
    if (wid == 0) { const float tv = TOT[((size_t)b * 8 + h) * NCHUNK + lane]; const float inc = wave_incl_scan(tv, lane); pre[lane] = inc - tv; }
    LDS_WAIT(); __syncthreads();
    const float* cl = CL + ((size_t)b * 8 + h) * SEQ;
    const float cref = (cl[q0] + pre[q0 >> 7]) * LOG2E;
    int dead = 0;
    const float SH = fminf(60.0f, fmaxf(0.0f, 120.0f - 2.0f * G2));
    if (tid < NT) { const int jn = 64 * tid + 63; dead = (cref - (cl[jn] + pre[jn >> 7]) * LOG2E < -160.0f + SH) ? 1 : 0; }
    const int tmin = __syncthreads_count(dead);
    const int nt = NT - tmin;
    for (int jx = 64 * tmin + tid; jx < q0 + 256; jx += 512) cbuf[jx] = (cl[jx] + pre[jx >> 7]) * LOG2E;
    bf16x8 qr[4];
#pragma unroll
    for (int d0 = 0; d0 < 4; ++d0) qr[d0] = *(const bf16x8*)(Qw + (size_t)r32 * pitch + d0 * 16 + hi * 8);
    u32x4 kreg, vreg;
    kreg = *(const u32x4*)(ksrc + (size_t)(NT - 1) * 64 * pitch); *(LAS u32x4*)(lds + A_K + stoff) = kreg;
    if (nt > 1) { kreg = *(const u32x4*)(ksrc + (size_t)(NT - 2) * 64 * pitch); *(LAS u32x4*)(lds + A_K + 8192 + stoff) = kreg; }
    LDS_WAIT(); __syncthreads();
    f32x16 cinit; { const float cq = cbuf[qidx] - G2 - SH;
#pragma unroll
      for (int r = 0; r < 16; ++r) cinit[r] = cq; }
    f32x16 o[2];
#pragma unroll
    for (int r = 0; r < 16; ++r) { o[0][r] = 0.f; o[1][r] = 0.f; }
    float lrun = 0.f;
    const int wq1 = q0 + wid * 32 + 32;
    f32x16 c0 = cinit, c1 = cinit, n0 = cinit, n1 = cinit;
    bf16x8 pa0 = {0, 0, 0, 0, 0, 0, 0, 0}, pa1 = pa0, pa2 = pa0, pa3 = pa0;
    bool lv_prev = false;
#define FOX_QK(C0, C1, BUF) do { const LAS unsigned char* kb_ = lds + A_K + (BUF) * 8192 + hi * 1024 + r32 * 16; bf16x8 kf_[8]; \
        _Pragma("unroll") for (int d0 = 0; d0 < 4; ++d0) { kf_[2 * d0] = *(const LAS bf16x8*)(kb_ + d0 * 2048); kf_[2 * d0 + 1] = *(const LAS bf16x8*)(kb_ + d0 * 2048 + 512); } \
        __builtin_amdgcn_sched_barrier(0);     \
        C0 = MFMA32(kf_[0], qr[0], cinit); C1 = MFMA32(kf_[1], qr[0], cinit);     \
        _Pragma("unroll") for (int d0 = 1; d0 < 4; ++d0) { C0 = MFMA32(kf_[2 * d0], qr[d0], C0); C1 = MFMA32(kf_[2 * d0 + 1], qr[d0], C1); } \
        __builtin_amdgcn_sched_barrier(0); } while (0)
#define FOX_PV(BUF) do { const LAS unsigned char* vb_ = lds + A_V + (BUF) * 8192 + ((lane >> 4) & 1) * 32 + (lane & 3) * 8 + (4 * hi + ((lane & 15) >> 2)) * 64; \
        bf16x8 vf_[8]; \
        _Pragma("unroll") for (int i_ = 0; i_ < 8; ++i_) vf_[i_] = __builtin_shufflevector(vtr(vb_ + (i_ >> 2) * 4096 + (i_ & 3) * 1024), vtr(vb_ + (i_ >> 2) * 4096 + (i_ & 3) * 1024 + 512), 0, 1, 2, 3, 4, 5, 6, 7); \
        __builtin_amdgcn_sched_barrier(0); \
        _Pragma("unroll") for (int d0 = 0; d0 < 2; ++d0) { \
            o[d0] = MFMA32(pa0, vf_[4 * d0], o[d0]); o[d0] = MFMA32(pa1, vf_[4 * d0 + 1], o[d0]); o[d0] = MFMA32(pa2, vf_[4 * d0 + 2], o[d0]); o[d0] = MFMA32(pa3, vf_[4 * d0 + 3], o[d0]); } \
        __builtin_amdgcn_sched_barrier(0); } while (0)
    if ((NT - 1) * 64 < wq1) FOX_QK(c0, c1, 0);
    LDS_WAIT(); __syncthreads();
#define FOX_ITER(IT, CU0, CU1, NX0, NX1) do { const int it_ = (IT); const int t = NT - 1 - it_; \
        if (it_ + 2 < nt) kreg = *(const u32x4*)(ksrc + (size_t)(t - 2) * 64 * pitch); \
        vreg = *(const u32x4*)(vsrc + (size_t)t * 64 * pitch); \
        const bool lv_cur = (t * 64 < wq1), lv_next = (it_ + 1 < nt) && ((t - 1) * 64 < wq1); \
        if (lv_next) FOX_QK(NX0, NX1, (it_ + 1) & 1); \
        if (lv_prev) FOX_PV((it_ - 1) & 1); \
        if (lv_cur) { \
            const LAS f32x4* cb4 = (const LAS f32x4*)(cbuf + t * 64 + 4 * hi); \
            _Pragma("unroll") for (int g = 0; g < 4; ++g) { const f32x4 b0 = cb4[2 * g], b1 = cb4[2 * g + 8]; \
                _Pragma("unroll") for (int i = 0; i < 4; ++i) { CU0[4 * g + i] -= b0[i]; CU1[4 * g + i] -= b1[i]; } } \
            if (t * 64 + 63 >= q0 + wid * 32) { \
                _Pragma("unroll") for (int r = 0; r < 16; ++r) { const int key = t * 64 + crow(r, hi); if (key > qidx) CU0[r] = -INFINITY; if (key + 32 > qidx) CU1[r] = -INFINITY; } \
            } \
            float ps = 0.f; \
            _Pragma("unroll") for (int r = 0; r < 16; ++r) { CU0[r] = __builtin_amdgcn_exp2f(CU0[r]); CU1[r] = __builtin_amdgcn_exp2f(CU1[r]); ps += CU0[r] + CU1[r]; } \
            lrun += ps; \
            pa0 = pack8(CU0, 0); pa1 = pack8(CU0, 1); pa2 = pack8(CU1, 0); pa3 = pack8(CU1, 1); \
        } \
        if (it_ + 2 < nt) *(LAS u32x4*)(lds + A_K + (it_ & 1) * 8192 + stoff) = kreg; \
        *(LAS u32x4*)(lds + A_V + (it_ & 1) * 8192 + stoff) = vreg; \
        LDS_WAIT(); __syncthreads(); \
        lv_prev = lv_cur; } while (0)
    for (int it = 0; it < nt; it += 2) { FOX_ITER(it, c0, c1, n0, n1); if (it + 1 < nt) FOX_ITER(it + 1, n0, n1, c0, c1); }
#undef FOX_ITER
    if (lv_prev) FOX_PV((nt - 1) & 1);
#undef FOX_QK
#undef FOX_PV
    lrun += __shfl_xor(lrun, 32);
    if (hi == 0) wsf[r32] = lrun;
    LDS_WAIT();
    f32x16 linv;
#pragma unroll
    for (int g = 0; g < 4; ++g) { const f32x4 lv = *(const LAS f32x4*)(wsf + 8 * g + 4 * hi);
#pragma unroll
        for (int i = 0; i < 4; ++i) linv[4 * g + i] = 1.0f / lv[i]; }
    { bf16_t* Ow = Op + (rowbase + q0 + wid * 32) * DM + h * 64;
      LAS bf16_t* stg = (LAS bf16_t*)(lds + A_OST) + wid * 2048;
#pragma unroll
      for (int r = 0; r < 16; ++r) { const int orow = crow(r, hi);
#pragma unroll
          for (int d0 = 0; d0 < 2; ++d0) { const float v = o[d0][r] * linv[r]; stg[orow * 64 + d0 * 32 + r32] = (bf16_t)(cvtpk(v, v) & 0xffffu); } }
      LDS_WAIT();
#pragma unroll
      for (int i = 0; i < 4; ++i) { const u32x4 v = *(const LAS u32x4*)(stg + lane * 8 + i * 512); *(u32x4*)(Ow + (size_t)(lane >> 3) * DM + (lane & 7) * 8 + (size_t)i * 8 * DM) = v; } }
    LDS_WAIT(); __syncthreads();
}
DI void fox_phase(const Frame& F, const bf16_t* Qp, const bf16_t* Kp, const bf16_t* Vp, int pitch, bf16_t* Op, const float* CL, const float* TOT, const float* qkg, unsigned* ctr) {
    float gq = 0.f, gk = 0.f;
    for (int i = 0; i < 64; ++i) { gq = fmaxf(gq, fabsf(qkg[i])); gk = fmaxf(gk, fabsf(qkg[64 + i])); }
    const float G2 = 64.0f * gq * gk * QSC * 1.02f + 0.5f;
    LAS int* uq = (LAS int*)(F.lds + A_FLG + 128);
    for (;;) {
        if (F.tid == 0) *uq = (int)__hip_atomic_fetch_add(ctr, 1u, __ATOMIC_RELAXED, __HIP_MEMORY_SCOPE_AGENT);
        LDS_WAIT(); __syncthreads();
        const int u = *uq;
        LDS_WAIT(); __syncthreads();
        if (u >= NB * 8 * 32) break;
        const int qb = 31 - (u >> 5), bh = u & 31;
        fox_unit(bh >> 3, bh & 7, qb, Qp, Kp, Vp, pitch, Op, CL, TOT, G2, F.lds, F.tid);
    }
}
template <int MODE> DI void attn_phase(const Frame& F, const bf16_t* Qp, const bf16_t* Kp, const bf16_t* Vp, int pitch, bf16_t* Op, const float* CL, const float* TOT, int nh, unsigned* ctr) {
    LAS int* uq = (LAS int*)(F.lds + A_FLG + 128);
    const int nunits = NB * nh * 32;
    for (;;) {
        if (F.tid == 0) *uq = (int)__hip_atomic_fetch_add(ctr, 1u, __ATOMIC_RELAXED, __HIP_MEMORY_SCOPE_AGENT);
        LDS_WAIT(); __syncthreads();
        const int u = *uq;
        LDS_WAIT(); __syncthreads();
        if (u >= nunits) break;
        const int nbh = NB * nh, qb = 31 - u / nbh, bh = u - (31 - qb) * nbh;
        attn_unit<MODE>(bh / nh, bh % nh, qb, Qp, Kp, Vp, pitch, Op, CL, TOT, nh, F.lds, F.tid);
    }
}

#define XB_TMO      128
#define XB_XCNT(j)  (256  + 64 * (j))
#define XB_XSUB(j)  (1280 + 64 * (j))
#define XB_XGEN(j)  (2304 + 64 * (j))
#define XB_TOP      3328
#define XB_TOPGEN   3392
#define XCD_BAR_WORDS 3456
#define XB_SPIN_CAP (1u << 18)

__device__ __forceinline__ unsigned xb_ld(unsigned* p)              { return __hip_atomic_load(p, __ATOMIC_RELAXED, __HIP_MEMORY_SCOPE_AGENT); }
__device__ __forceinline__ unsigned xb_add(unsigned* p, unsigned v) { return __hip_atomic_fetch_add(p, v, __ATOMIC_RELAXED, __HIP_MEMORY_SCOPE_AGENT); }
__device__ __forceinline__ unsigned xb_xcc_id() { return (unsigned)__builtin_amdgcn_s_getreg((3 << 11) | 20) & 0xFu; }
#define XB_SPIN(cond, bar) do { unsigned _sp = 0; while (cond) { __builtin_amdgcn_s_sleep(1); \
    if ((++_sp & 255u) == 0u) { if (xb_ld(&(bar)[XB_TMO])) break; if (_sp > XB_SPIN_CAP) { atomicAdd(&(bar)[XB_TMO], 1u); break; } } } } while (0)

struct XcdBarrier {
    unsigned* bar; unsigned x;
    volatile LAS unsigned* st;
};

__device__ __forceinline__ XcdBarrier xcd_barrier_post(unsigned* bar, volatile LAS unsigned* st) {
    XcdBarrier b; b.bar = bar; b.x = xb_xcc_id(); b.st = st;
    if (threadIdx.x == 0) (void)xb_add(&bar[XB_XCNT(b.x)], 1u);
    return b;
}
__device__ __forceinline__ void xcd_barrier_complete(unsigned* bar, unsigned x, unsigned& nloc, unsigned& nx) {
    const unsigned G = gridDim.x * gridDim.y * gridDim.z;
    unsigned sum, cnt, mine, sp = 0u;
    for (;;) {
        sum = 0u; cnt = 0u; mine = 0u;
#pragma unroll
        for (unsigned j = 0; j < 16; ++j) { const unsigned c = xb_ld(&bar[XB_XCNT(j)]); sum += c; cnt += (c > 0u) ? 1u : 0u; mine = (j == x) ? c : mine; }
        if (sum == G) break;
        __builtin_amdgcn_s_sleep(1);
        if ((++sp & 255u) == 0u) { if (xb_ld(&bar[XB_TMO])) break; if (sp > XB_SPIN_CAP) { atomicAdd(&bar[XB_TMO], 1u); break; } }
    }
    nloc = mine > 0u ? mine : 1u; nx = cnt > 0u ? cnt : 1u;
}

__device__ __forceinline__ void xcd_barrier(const XcdBarrier& b) {
    asm volatile("s_waitcnt vmcnt(0)" ::: "memory");
    __syncthreads();
    if (threadIdx.x == 0) {
        unsigned* bar = b.bar;
        __builtin_amdgcn_s_waitcnt(0);
        unsigned nloc = b.st[0], nx = b.st[1];
        if (nloc == 0u) { xcd_barrier_complete(bar, b.x, nloc, nx); b.st[0] = nloc; b.st[1] = nx; }
        const unsigned old = xb_add(&bar[XB_XSUB(b.x)], 1u);
        const unsigned gen = old / nloc;
        if (old + 1u == (gen + 1u) * nloc) {
            __builtin_amdgcn_fence(__ATOMIC_RELEASE, "agent");
            asm volatile("s_waitcnt vmcnt(0)" ::: "memory");
            const unsigned og = xb_add(&bar[XB_TOP], 1u);
            const unsigned tg = og / nx;
            if (og + 1u == (tg + 1u) * nx) xb_add(&bar[XB_TOPGEN], 1u);
            else XB_SPIN(xb_ld(&bar[XB_TOPGEN]) == tg, bar);
            __builtin_amdgcn_fence(__ATOMIC_ACQUIRE, "agent");
            xb_add(&bar[XB_XGEN(b.x)], 1u);
            asm volatile("s_waitcnt vmcnt(0)" ::: "memory");
        } else {
            XB_SPIN(xb_ld(&bar[XB_XGEN(b.x)]) == gen, bar);
            __builtin_amdgcn_fence(__ATOMIC_ACQUIRE, "agent");
            asm volatile("s_waitcnt vmcnt(0)" ::: "memory");
        }
    }
    __syncthreads();
}

constexpr int N_PHASES = 33;
__host__ __device__ inline bool phase_empty(int p) { if (p == 0) return false; const int L = (p - 1) >> 3, st = (p - 1) & 7; return (L & 1) && st == 3; }
__global__ void __launch_bounds__(512, 2) mk_fwd(Args a) {
    extern __shared__ __attribute__((aligned(16))) unsigned char lds_raw[];
    cg::grid_group grid = cg::this_grid();
    volatile LAS unsigned* bst = (volatile LAS unsigned*)((LAS unsigned char*)lds_raw + 131072 + 4032);
    if (threadIdx.x < 2) bst[threadIdx.x] = 0u;
    __syncthreads();
    XcdBarrier xbar = xcd_barrier_post((unsigned*)(a.ws + WS_CTL), bst);
    bool first_sync = true; bool redo = false; (void)redo;
    for (int p = a.ph_lo; p < a.ph_hi; ++p) {
        if (phase_empty(p)) continue;
        Frame F; F.lds = (LAS unsigned char*)lds_raw; { int t_ = threadIdx.x; asm volatile("" : "+v"(t_)); F.tid = t_; } F.lane = F.tid & 63; F.wave = __builtin_amdgcn_readfirstlane(F.tid >> 6);
        F.G = gridDim.x; { int bx = blockIdx.x; asm volatile("" : "+s"(bx)); F.bx = bx; F.vcu = (F.G % 8 == 0) ? (bx % 8) * (F.G / 8) + bx / 8 : bx; }
        { int z_ = 0; asm volatile("" : "+s"(z_)); F.z = z_; }
        unsigned char* ws = a.ws; asm volatile("" : "+s"(ws));
        const bf16_t* XB = (const bf16_t*)(ws + WS_XH); float* SSQ = (float*)(ws + WS_SSQ); bf16_t* BIG = (bf16_t*)(ws + WS_BIG); bf16_t* YB = (bf16_t*)(ws + WS_YB);
        if (p == 0) {
#ifndef NO_P0
            for (int rep_ = 0; rep_ < REP_P0; ++rep_) p0_prologue(F, a, ws);
#endif
        }
        else {
            const int L = (p - 1) >> 3, st = (p - 1) & 7, e = L >> 1; const bool hyb = !(L & 1);
            if (st == 0 || st == 6) {
                const int mi = L * 2 + (st == 6 ? 1 : 0);
                pg8::Gemm g{XB, (const bf16_t*)(ws + WS_WFI + mi * SZ_WFI), TOK, 2 * DFF, DM}; pg8::StaticOrder S; S.init(TOK, 2 * DFF, F.G, F.bx);
                pg8::EpiSwiglu E{BIG, DFF, SSQ};
                pg8::gemm_phase<pg8::EpiSwiglu, pg8::StaticOrder, true, true, true>(F.lds, g, S, E, F.tid);
            } else if (st == 1 || st == 7 || st == 5) {
                pg8::Gemm g; float* xo = a.out; asm volatile("" : "+s"(xo)); float alpha = 0.5f; if (p != N_PHASES - 1) xo = nullptr;
                if (st == 5) { g = pg8::Gemm{YB, (const bf16_t*)(ws + (hyb ? WS_WHO : WS_WSO) + e * SZ_W1K), TOK, DM, DM}; alpha = 1.0f; }
                else { const int mi = L * 2 + (st == 7 ? 1 : 0); g = pg8::Gemm{BIG, (const bf16_t*)(ws + WS_WFO + mi * SZ_WFO), TOK, DM, DFF}; }
                pg8::StaticOrder S; S.init(TOK, DM, F.G, F.bx);
                pg8::EpiRes E{xo, (_Float16*)(ws + WS_XH), SSQ, alpha};
                pg8::gemm_phase<pg8::EpiRes, pg8::StaticOrder, true, true>(F.lds, g, S, E, F.tid);
            } else if (st == 2) {
                const int N = hyb ? HYW : SBW;
                pg8::Gemm g{XB, (const bf16_t*)(ws + (hyb ? WS_WHI + e * SZ_WHI : WS_WSQ + e * SZ_WSQ)), TOK, N, DM}; pg8::StaticOrder S; S.init(TOK, N, F.G, F.bx);
                pg8::EpiProj E{BIG, N, SSQ, hyb ? 0 : 1024, QSC};
                pg8::gemm_phase<pg8::EpiProj, pg8::StaticOrder, true, true, true>(F.lds, g, S, E, F.tid);
            } else if (st == 3) {

#ifndef NO_PA
                for (int rep_ = 0; rep_ < REP_PA; ++rep_) rglru_passA(F, a, e, ws);
#endif
#ifndef NO_PREP
                if (!redo) hy_prep(F, a, e, ws);
#endif

            } else {

#ifndef NO_FOX
                if (hyb) { fox_phase(F, BIG + 1024, BIG + 1536, BIG + 2048, HYW, YB + 512, (const float*)(ws + WS_CL), (const float*)(ws + WS_TOT), a.in[12 + F.z] + (size_t)e * 128, (unsigned*)(ws + WS_CTL) + 3600 + 64 * e); rglru_passC(F, ws); }
#endif
#ifndef NO_SB
                if (!hyb) attn_phase<1>(F, BIG, BIG + 1024, BIG + 2048, SBW, YB, nullptr, nullptr, 16, (unsigned*)(ws + WS_CTL) + 3800 + 64 * e);
#endif

            }
        }
#if REP_F1 == 2
        { static_assert(true, ""); const int st_ = (p - 1) & 7; if (p > 0 && p < 9 && (st_ == REP_ST0 || st_ == REP_ST1)) { if (!redo) { redo = true; --p; } else redo = false; } }
#endif
        if (p + 1 < a.ph_hi) { if (first_sync) { grid.sync(); first_sync = false; } else xcd_barrier(xbar); }
    }
}

#ifndef REP_SB
#define REP_SB 1
#endif
#ifndef REP_FOX
#define REP_FOX 2
#endif
#ifndef MK_MULTI
#define MK_MULTI 0
#endif
extern "C" void kernel_launch(void* const* d_in, const int* in_sizes, int n_in, void* d_out, int out_size, void* d_ws, size_t ws_size, hipStream_t stream) {
    static int grid = 0;
    if (grid == 0) {
        if (n_in != 16 || in_sizes[0] != TOK * DM || out_size != TOK * DM || ws_size < WS_END) { fprintf(stderr, "kernel_launch: unexpected shapes / workspace (n_in %d, ws %zu, need %zu)\n", n_in, ws_size, (size_t)WS_END); grid = -1; return; }
        int dev = 0, cus = 0, per_cu = 0;
        hipGetDevice(&dev); hipDeviceGetAttribute(&cus, hipDeviceAttributeMultiprocessorCount, dev);
        if (hipFuncSetAttribute((const void*)mk_fwd, hipFuncAttributeMaxDynamicSharedMemorySize, LDS_BYTES) != hipSuccess) { fprintf(stderr, "kernel_launch: hipFuncSetAttribute failed\n"); grid = -1; return; }
        if (hipOccupancyMaxActiveBlocksPerMultiprocessor(&per_cu, (const void*)mk_fwd, 512, LDS_BYTES) != hipSuccess || per_cu < 1) { fprintf(stderr, "kernel_launch: occupancy query says %d\n", per_cu); per_cu = 1; }
        (void)hipGetLastError();
        grid = cus;
    }
    if (grid < 0) return;
    Args a{};
    if (hipMemsetAsync((char*)d_ws + WS_CTL, 0, 16384, stream) != hipSuccess) { fprintf(stderr, "kernel_launch: memset of the barrier words failed\n"); return; }
    for (int i = 0; i < 16; ++i) a.in[i] = (const float*)d_in[i];
    a.out = (float*)d_out; a.ws = (unsigned char*)d_ws;
#if MK_MULTI
    for (int p = 0; p < N_PHASES; ++p) { if (phase_empty(p)) continue; a.ph_lo = p; a.ph_hi = p + 1; hipLaunchKernelGGL(mk_fwd, dim3(grid), dim3(512), LDS_BYTES, stream, a); }
#else
    a.ph_lo = 0; a.ph_hi = N_PHASES;
    void* args[] = {&a};
    hipError_t e = hipLaunchCooperativeKernel((const void*)mk_fwd, dim3(grid), dim3(512), args, LDS_BYTES, stream);
    if (e != hipSuccess) fprintf(stderr, "cooperative launch failed: %s (grid %d)\n", hipGetErrorString(e), grid);
#endif
}
```
